# Optimizing an MI355X kernel written in HIP

```python
import jax
import jax.numpy as jnp
from jax import lax
import numpy as np

D_MODEL = 1024
BATCH = 16
SEQ = 2048
DEPTH = 2

GRID_W = 64
CTX_LEN = 256
MLA_HEADS = 8
QK_NOPE = 64
QK_ROPE = 32
V_HEAD = 64
Q_LORA = 256
KV_LORA = 128
Q_BLOCK = 128
CONV_CH = 256
CONV_WIDTH = 31
ML_HEADS = 4
ML_HEAD_DIM = 64
ML_WIDTH = ML_HEADS * ML_HEAD_DIM
MLSTM_CHUNK = 128
D_FF = 4 * D_MODEL
MIX_WIDTH = MLA_HEADS * V_HEAD + CONV_CH + ML_WIDTH
ROPE_THETA = 10000.0
LN_EPS = 1e-5
RMS_EPS = 1e-6
DEEPNORM_ALPHA = (2 * DEPTH) ** 0.25
DEEPNORM_BETA = (8 * DEPTH) ** -0.25
IN_SIZES = (Q_LORA, KV_LORA, QK_ROPE, 2 * CONV_CH, ML_WIDTH, ML_WIDTH, ML_WIDTH, ML_WIDTH, 4 * ML_HEADS)
IN_COLS = sum(IN_SIZES)

kernel_name = "hybrid_mla_conformer_mlstm_dit_block"


def layer_norm(x, g, b):
    xf = x.astype(jnp.float32)
    mu = jnp.mean(xf, -1, keepdims=True)
    var = jnp.mean(jnp.square(xf - mu), -1, keepdims=True)
    return ((xf - mu) * lax.rsqrt(var + LN_EPS) * g + b).astype(x.dtype)


def rms_norm(x, g):
    xf = x.astype(jnp.float32)
    return (xf * lax.rsqrt(jnp.mean(jnp.square(xf), -1, keepdims=True) + RMS_EPS) * g).astype(x.dtype)


def split_cols(p):
    parts, off = [], 0
    for size in IN_SIZES:
        parts.append(p[..., off:off + size])
        off += size
    return parts


def axial_rope(t):
    n = t.shape[-2]
    rows = n // GRID_W
    pos = jnp.arange(rows * GRID_W)
    row, col = pos // GRID_W, pos % GRID_W
    half = QK_ROPE // 2
    nf = half // 2
    inv_freq = ROPE_THETA ** (-jnp.arange(nf, dtype=jnp.float32) / nf)

    def rot(xa, p):
        ang = p.astype(jnp.float32)[:, None] * inv_freq
        cos, sin = jnp.cos(ang), jnp.sin(ang)
        x1 = xa[..., :nf].astype(jnp.float32)
        x2 = xa[..., nf:].astype(jnp.float32)
        return jnp.concatenate([x1 * cos - x2 * sin, x1 * sin + x2 * cos], -1)

    out = jnp.concatenate([rot(t[..., :half], row), rot(t[..., half:], col)], -1)
    return out.astype(t.dtype)


def mla_project(cq, ckv, kr, g_qn, w_uq, g_kvn, w_ukv, with_rope):
    B, L, _ = cq.shape
    q = (rms_norm(cq, g_qn) @ w_uq).reshape(B, L, MLA_HEADS, QK_NOPE + QK_ROPE).transpose(0, 2, 1, 3)
    kv = (rms_norm(ckv, g_kvn) @ w_ukv).reshape(B, L, MLA_HEADS, QK_NOPE + V_HEAD).transpose(0, 2, 1, 3)
    q_nope, q_rope = q[..., :QK_NOPE], q[..., QK_NOPE:]
    k_nope, v = kv[..., :QK_NOPE], kv[..., QK_NOPE:]
    k_rope = kr[:, None]
    if with_rope:
        q_rope = axial_rope(q_rope)
        k_rope = axial_rope(k_rope)
    k_rope = jnp.broadcast_to(k_rope, (B, MLA_HEADS, L, QK_ROPE))
    return (jnp.concatenate([q_nope, q_rope], -1), jnp.concatenate([k_nope, k_rope], -1), v)


def attend(q, k, v):
    scale = (QK_NOPE + QK_ROPE) ** -0.5
    s = jnp.einsum('bhqd,bhkd->bhqk', q, k).astype(jnp.float32) * scale
    p = jax.nn.softmax(s, axis=-1).astype(v.dtype)
    return jnp.einsum('bhqk,bhkd->bhqd', p, v)


def blocked_attend(q, k, v):
    B, H, S, dq = q.shape
    nb = S // Q_BLOCK
    qb = q.reshape(B, H, nb, Q_BLOCK, dq).transpose(2, 0, 1, 3, 4)
    ob = lax.map(lambda qq: attend(qq, k, v), qb)
    return ob.transpose(1, 2, 0, 3, 4).reshape(B, H, S, -1)


def merge_heads(o):
    B, H, L, d = o.shape
    return o.transpose(0, 2, 1, 3).reshape(B, L, H * d)


def conformer_conv(u, w, b, ln_g, ln_b):
    a, gt = u[..., :CONV_CH], u[..., CONV_CH:]
    z = a * jax.nn.sigmoid(gt)
    z = lax.conv_general_dilated(
        z, w[:, None, :].astype(z.dtype), window_strides=(1,),
        padding=[(CONV_WIDTH // 2, CONV_WIDTH // 2)],
        dimension_numbers=('NWC', 'WIO', 'NWC'), feature_group_count=CONV_CH) + b
    return jax.nn.silu(layer_norm(z, ln_g, ln_b))


def mlstm_chunkwise(q, k, v, log_i, log_f, state):
    B, H, L, d = q.shape
    T = MLSTM_CHUNK
    nc = L // T
    tril = jnp.tril(jnp.ones((T, T), dtype=bool))

    def chunks(t):
        return jnp.moveaxis(t.astype(jnp.float32).reshape(t.shape[:2] + (nc, T) + t.shape[3:]), 2, 0)

    def step(carry, inp):
        C, n, m = carry
        qc, kc, vc, lic, lfc = inp
        b = jnp.cumsum(lfc, axis=-1)
        dmat = b[..., :, None] - b[..., None, :] + lic[..., None, :]
        dmat = jnp.where(tril, dmat, -jnp.inf)
        m_inter = b + m[..., None]
        m_t = jnp.maximum(m_inter, jnp.max(dmat, axis=-1))
        wts = jnp.exp(dmat - m_t[..., None])
        inter = jnp.exp(m_inter - m_t)
        sqk = jnp.einsum('bhtd,bhsd->bhts', qc, kc) * wts
        num = jnp.einsum('bhts,bhsd->bhtd', sqk, vc) + inter[..., None] * jnp.einsum('bhvk,bhtk->bhtv', C, qc)
        den = jnp.sum(sqk, -1) + inter * jnp.einsum('bhk,bhtk->bht', n, qc)
        h = num / jnp.maximum(jnp.abs(den), jnp.exp(-m_t))[..., None]
        b_last = b[..., -1]
        g = b_last[..., None] - b + lic
        m_new = jnp.maximum(b_last + m, jnp.max(g, axis=-1))
        w_upd = jnp.exp(g - m_new[..., None])
        decay = jnp.exp(b_last + m - m_new)
        C_new = decay[..., None, None] * C + jnp.einsum('bhs,bhsv,bhsk->bhvk', w_upd, vc, kc)
        n_new = decay[..., None] * n + jnp.einsum('bhs,bhsk->bhk', w_upd, kc)
        return (C_new, n_new, m_new), h

    final, hs = lax.scan(step, state, (chunks(q), chunks(k), chunks(v), chunks(log_i), chunks(log_f)))
    return jnp.moveaxis(hs, 0, 2).reshape(B, H, L, d), final


def to_heads(t):
    B, L, _ = t.shape
    return t.reshape(B, L, ML_HEADS, ML_HEAD_DIM).transpose(0, 2, 1, 3)


def gate_logs(pre, b_gates):
    g = jnp.moveaxis((pre + b_gates).astype(jnp.float32), -1, 1)
    i_f, f_f, i_b, f_b = jnp.split(g, 4, axis=1)
    return i_f, jax.nn.log_sigmoid(f_f), i_b, jax.nn.log_sigmoid(f_b)


def mlstm_bidirectional(q_l, k_l, v_l, gate_l, q_c, k_c, v_c, gate_c, b_gates):
    B = q_l.shape[0]
    ks = ML_HEAD_DIM ** -0.5
    ql, kl, vl = to_heads(q_l), to_heads(k_l) * ks, to_heads(v_l)
    qc, kc, vc = to_heads(q_c), to_heads(k_c) * ks, to_heads(v_c)
    il_f, fl_f, il_b, fl_b = gate_logs(gate_l, b_gates)
    ic_f, fc_f, ic_b, fc_b = gate_logs(gate_c, b_gates)
    zero = (jnp.zeros((B, ML_HEADS, ML_HEAD_DIM, ML_HEAD_DIM), jnp.float32),
            jnp.zeros((B, ML_HEADS, ML_HEAD_DIM), jnp.float32),
            jnp.zeros((B, ML_HEADS), jnp.float32))
    hc_f, st_f = mlstm_chunkwise(qc, kc, vc, ic_f, fc_f, zero)
    hl_f, _ = mlstm_chunkwise(ql, kl, vl, il_f, fl_f, st_f)
    flip = lambda t: jnp.flip(t, axis=2)
    hc_b, st_b = mlstm_chunkwise(flip(qc), flip(kc), flip(vc), flip(ic_b), flip(fc_b), zero)
    hl_b, _ = mlstm_chunkwise(flip(ql), flip(kl), flip(vl), flip(il_b), flip(fl_b), st_b)
    return hl_f + flip(hl_b), hc_f + flip(hc_b)


def mlstm_out(h, o_pre, g):
    B, H, L, d = h.shape
    hh = h.transpose(0, 2, 1, 3) * jax.nn.sigmoid(o_pre.astype(jnp.float32)).reshape(B, L, H, d)
    mu = jnp.mean(hh, -1, keepdims=True)
    var = jnp.mean(jnp.square(hh - mu), -1, keepdims=True)
    hn = (hh - mu) * lax.rsqrt(var + LN_EPS)
    return (hn.reshape(B, L, H * d) * g).astype(o_pre.dtype)


def sqrelu_mlp(u, w1, b1, w2, b2):
    h = jax.nn.relu(u @ w1 + b1)
    return (h * h) @ w2 + b2


def trunk_layer(x, ctx, c, c_ctx, w_ada, b_ada, w_in, g_qn, w_uq, g_kvn, w_ukv,
                conv_w, conv_b, conv_ln_g, conv_ln_b, b_gates, ml_norm_g, w_out,
                ln1_g, ln1_b, w_mlp1, b_mlp1, w_mlp2, b_mlp2, ln2_g, ln2_b, is_last):
    mod = jax.nn.silu(c) @ w_ada + b_ada
    sh1, sc1, g1, sh2, sc2, g2 = jnp.split(mod[:, None, :], 6, axis=-1)
    cmod = jax.nn.silu(c_ctx) @ w_ada + b_ada
    csh1, csc1, cg1, csh2, csc2, cg2 = jnp.split(cmod, 6, axis=-1)

    cq, ckv, kr, conv_in, mq, mk, mv, mo, mg = split_cols((x * (1 + sc1) + sh1) @ w_in)
    ccq, cckv, ckr, cconv_in, cmq, cmk, cmv, cmo, cmg = split_cols((ctx * (1 + csc1) + csh1) @ w_in)

    q_l, k_l, v_l = mla_project(cq, ckv, kr, g_qn, w_uq, g_kvn, w_ukv, True)
    q_c, k_c, v_c = mla_project(ccq, cckv, ckr, g_qn, w_uq, g_kvn, w_ukv, False)
    att = merge_heads(blocked_attend(q_l, jnp.concatenate([k_l, k_c], 2), jnp.concatenate([v_l, v_c], 2)))
    conv = conformer_conv(conv_in, conv_w, conv_b, conv_ln_g, conv_ln_b)
    h_l, h_c = mlstm_bidirectional(mq, mk, mv, mg, cmq, cmk, cmv, cmg, b_gates)
    ml = mlstm_out(h_l, mo, ml_norm_g)

    y = jnp.concatenate([att, conv, ml], -1) @ w_out
    x = layer_norm(DEEPNORM_ALPHA * x + g1 * y, ln1_g, ln1_b)
    x = layer_norm(DEEPNORM_ALPHA * x + g2 * sqrelu_mlp(x * (1 + sc2) + sh2, w_mlp1, b_mlp1, w_mlp2, b_mlp2),
                   ln2_g, ln2_b)

    if not is_last:
        att_c = merge_heads(attend(q_c, k_c, v_c))
        conv_c = conformer_conv(cconv_in, conv_w, conv_b, conv_ln_g, conv_ln_b)
        ml_c = mlstm_out(h_c, cmo, ml_norm_g)
        yc = jnp.concatenate([att_c, conv_c, ml_c], -1) @ w_out
        ctx = layer_norm(DEEPNORM_ALPHA * ctx + cg1 * yc, ln1_g, ln1_b)
        ctx = layer_norm(DEEPNORM_ALPHA * ctx + cg2 * sqrelu_mlp(ctx * (1 + csc2) + csh2, w_mlp1, b_mlp1,
                                                                 w_mlp2, b_mlp2), ln2_g, ln2_b)
    return x, ctx


def setup_inputs(seed: int = 0) -> dict:
    key = jax.random.key(seed)
    ks = iter(jax.random.split(key, 32))

    def nrm(shape, scale):
        return jax.random.normal(next(ks), shape, jnp.float32) * scale

    L = DEPTH
    D = D_MODEL
    x = nrm((BATCH, SEQ, D), 1.0)
    c = nrm((BATCH, D), 1.0)
    ctx = nrm((BATCH, CTX_LEN, D), 1.0)
    c_ctx = nrm((D,), 1.0)
    w_ada = nrm((L, D, 6 * D), D ** -0.5)
    b_ada = nrm((L, 6 * D), 0.02)
    w_in = nrm((L, D, IN_COLS), D ** -0.5)
    g_qn = 1.0 + nrm((L, Q_LORA), 0.05)
    w_uq = nrm((L, Q_LORA, MLA_HEADS * (QK_NOPE + QK_ROPE)), Q_LORA ** -0.5)
    g_kvn = 1.0 + nrm((L, KV_LORA), 0.05)
    w_ukv = nrm((L, KV_LORA, MLA_HEADS * (QK_NOPE + V_HEAD)), KV_LORA ** -0.5)
    conv_w = nrm((L, CONV_WIDTH, CONV_CH), CONV_WIDTH ** -0.5)
    conv_b = nrm((L, CONV_CH), 0.02)
    conv_ln_g = 1.0 + nrm((L, CONV_CH), 0.05)
    conv_ln_b = nrm((L, CONV_CH), 0.02)
    f_bias = jnp.linspace(3.0, 6.0, ML_HEADS)
    z = jnp.zeros((ML_HEADS,), jnp.float32)
    b_gates = jnp.concatenate([z, f_bias, z, f_bias])[None, :] + nrm((L, 4 * ML_HEADS), 0.1)
    ml_norm_g = 1.0 + nrm((L, ML_WIDTH), 0.05)
    w_out = nrm((L, MIX_WIDTH, D), MIX_WIDTH ** -0.5 * DEEPNORM_BETA)
    ln1_g = 1.0 + nrm((L, D), 0.05)
    ln1_b = nrm((L, D), 0.02)
    w_mlp1 = nrm((L, D, D_FF), D ** -0.5)
    b_mlp1 = nrm((L, D_FF), 0.02)
    w_mlp2 = nrm((L, D_FF, D), D_FF ** -0.5 * DEEPNORM_BETA)
    b_mlp2 = nrm((L, D), 0.02)
    ln2_g = 1.0 + nrm((L, D), 0.05)
    ln2_b = nrm((L, D), 0.02)
    return {"x": x, "c": c, "ctx": ctx, "c_ctx": c_ctx, "w_ada": w_ada, "b_ada": b_ada, "w_in": w_in,
            "g_qn": g_qn, "w_uq": w_uq, "g_kvn": g_kvn, "w_ukv": w_ukv, "conv_w": conv_w,
            "conv_b": conv_b, "conv_ln_g": conv_ln_g, "conv_ln_b": conv_ln_b, "b_gates": b_gates,
            "ml_norm_g": ml_norm_g, "w_out": w_out, "ln1_g": ln1_g, "ln1_b": ln1_b, "w_mlp1": w_mlp1,
            "b_mlp1": b_mlp1, "w_mlp2": w_mlp2, "b_mlp2": b_mlp2, "ln2_g": ln2_g, "ln2_b": ln2_b}


def reference(x, c, ctx, c_ctx, w_ada, b_ada, w_in, g_qn, w_uq, g_kvn, w_ukv, conv_w, conv_b,
              conv_ln_g, conv_ln_b, b_gates, ml_norm_g, w_out, ln1_g, ln1_b, w_mlp1, b_mlp1,
              w_mlp2, b_mlp2, ln2_g, ln2_b):
    for l in range(DEPTH):
        x, ctx = trunk_layer(x, ctx, c, c_ctx, w_ada[l], b_ada[l], w_in[l], g_qn[l], w_uq[l], g_kvn[l],
                             w_ukv[l], conv_w[l], conv_b[l], conv_ln_g[l], conv_ln_b[l], b_gates[l],
                             ml_norm_g[l], w_out[l], ln1_g[l], ln1_b[l], w_mlp1[l], b_mlp1[l], w_mlp2[l],
                             b_mlp2[l], ln2_g[l], ln2_b[l], l == DEPTH - 1)
    return x
```

```cpp
#include <hip/hip_runtime.h>
#include <hip/hip_bf16.h>
#include <cstdio>
#include <cstdint>

#ifndef MK_N_LAUNCHES
#define MK_N_LAUNCHES 20
#endif

#define LAS __attribute__((address_space(3)))
#define GAS __attribute__((address_space(1)))
typedef unsigned short bf16_t;
typedef short bf16x8 __attribute__((ext_vector_type(8)));
typedef short s16x4 __attribute__((ext_vector_type(4)));
typedef float f32x4 __attribute__((ext_vector_type(4)));
typedef float f32x2 __attribute__((ext_vector_type(2)));
typedef float f32x16 __attribute__((ext_vector_type(16)));
typedef unsigned u32x4 __attribute__((ext_vector_type(4)));
typedef unsigned u32x2 __attribute__((ext_vector_type(2)));

constexpr int NB = 16, SEQ = 2048, DM = 1024, CTXL = 256, DEPTH = 2;
constexpr int ML = NB * SEQ, MC = NB * CTXL, MT = ML + MC;
constexpr int NP = 2048;
constexpr int C_CQ = 0, C_CKV = 256, C_KR = 384, C_CA = 416, C_CG = 672, C_MQ = 928, C_MK = 1184, C_MV = 1440, C_MO = 1696, C_MG = 1952, IN_COLS = 1968;
constexpr int NUP = 1792, KUP = 384;
constexpr int DFF = 4096, NHEAD = 8, LKV = SEQ + CTXL;
constexpr int MLH = 4, NCHUNK = 18;
constexpr float LN_EPS = 1e-5f, RMS_EPS = 1e-6f, DN_ALPHA = 1.4142135623730951f;
constexpr float QSCALE = 0.10206207261596575f * 1.4426950408889634f;

constexpr size_t MiB = 1u << 20;
constexpr size_t WS_CTL = 0, CTL_ZERO_BYTES = 1 * MiB;
constexpr size_t WS_MOD = 1 * MiB;
constexpr size_t WS_ROPE = 2 * MiB;
constexpr size_t WS_RS = 2 * MiB + 512 * 1024;
constexpr size_t WS_GATE = 3 * MiB;
constexpr size_t WS_MSC = 5 * MiB + 512 * 1024;
constexpr size_t WS_MN = 6 * MiB;
constexpr size_t WS_W = 8 * MiB, W_LAYER = 24 * MiB;
constexpr size_t W_IN = 0, W_UP = 4 * MiB, W_OUT = 6 * MiB, W_1 = 8 * MiB, W_2 = 16 * MiB;
constexpr size_t WS_XM = 56 * MiB;
constexpr size_t WS_CST = WS_XM;
constexpr size_t WS_P = 128 * MiB;
constexpr size_t WS_Q = 272 * MiB, WS_QC = 320 * MiB;
constexpr size_t WS_K = 326 * MiB;
constexpr size_t WS_V = 380 * MiB;
constexpr size_t WS_MIX = 416 * MiB;
constexpr size_t WS_H = 128 * MiB;
constexpr size_t WS_CTXF = 488 * MiB;
constexpr size_t WS_END = 504 * MiB;
static_assert(WS_H + (size_t)MT * DFF * 2 <= WS_MIX && WS_V + (size_t)NB * NHEAD * LKV * 64 * 2 <= WS_MIX && WS_MIX + (size_t)MT * DM * 2 <= WS_CTXF, "ws map");
static_assert(WS_CST + (size_t)128 * NCHUNK * 4096 * 2 <= WS_P && WS_XM + (size_t)MT * DM * 2 <= WS_P, "ws map 2");

constexpr int LDS_BYTES = 147456;
constexpr int LDSCTL_OFF = LDS_BYTES - 512;
constexpr int PHASE_LDS = LDSCTL_OFF;

__device__ __forceinline__ unsigned f2bf(float f) { unsigned u = __builtin_bit_cast(unsigned, f); return (u + 0x7fffu + ((u >> 16) & 1u)) >> 16; }
__device__ __forceinline__ unsigned pk2(float lo, float hi) { return f2bf(lo) | (f2bf(hi) << 16); }
__device__ __forceinline__ float bf2f(unsigned h) { return __builtin_bit_cast(float, h << 16); }
__device__ __forceinline__ float bflo(unsigned w) { return __builtin_bit_cast(float, w << 16); }
__device__ __forceinline__ float bfhi(unsigned w) { return __builtin_bit_cast(float, w & 0xffff0000u); }
__device__ __forceinline__ float wave_sum(float v) {
#pragma unroll
    for (int o = 1; o < 64; o <<= 1) v += __shfl_xor(v, o);
    return v;
}
__device__ __forceinline__ float wave_max(float v) {
#pragma unroll
    for (int o = 1; o < 64; o <<= 1) v = fmaxf(v, __shfl_xor(v, o));
    return v;
}
__device__ __forceinline__ float sigmoidf_(float x) { return 1.0f / (1.0f + __expf(-x)); }
__device__ __forceinline__ float logsigmoidf_(float x) { return x < 0.f ? x - log1pf(expf(x)) : -log1pf(expf(-x)); }
__device__ __forceinline__ int crow(int r, int hi) { return (r & 3) + 8 * (r >> 2) + 4 * hi; }
__device__ __forceinline__ int otid() { int t = threadIdx.x; asm volatile("" : "+v"(t)); return t; }
#define LDS_WAIT() asm volatile("s_waitcnt lgkmcnt(0)" ::: "memory")
#define VM_WAIT() asm volatile("s_waitcnt vmcnt(0)" ::: "memory")

namespace pg8 {
constexpr int BM = 256, BK = 64, HALF = 128, HTB = HALF * BK * 2, STAGE_BYTES = 8 * HTB, NXCD = 8, WGM = 8;
__host__ __device__ __forceinline__ int lds_byte(int r, int c) { const int st = (r >> 4) * 2 + (c >> 5), rr = r & 15, cc = c & 31, ob = rr * 64 + cc * 2; return st * 1024 + (ob ^ (((ob >> 9) & 1) << 5)); }
__host__ __device__ __forceinline__ void stage_rc(int b, int& R, int& C) { const int st = b / 1024, sb = b % 1024, swz = sb ^ (((sb >> 9) & 1) << 5); R = (st >> 1) * 16 + swz / 64; C = (st & 1) * 32 + (swz % 64) / 2; }
__host__ __device__ __forceinline__ int perm32(int rho) { const int n = rho >> 4, i = rho & 15; return 8 * (i >> 2) + 4 * n + (i & 3); }

struct Unit { int pm, pn; };
struct Gemm { const bf16_t* A; const bf16_t* Bt; int M, N, K, lda; };

struct StaticOrder {
    int nM, nN, nwg, G, c;
    __host__ __device__ void init(int M, int N, int G_, int c_) { nM = M / BM; nN = N / BM; nwg = nM * nN; G = G_; c = c_; }
    __host__ __device__ bool next(int i, Unit& u) const {
        const long L = (long)i * G + c; if (L >= nwg) return false;
        int wgid = (int)L; { const int q = nwg / NXCD, r = nwg % NXCD, xcd = wgid % NXCD, off = wgid / NXCD; wgid = (xcd < r ? xcd * (q + 1) : r * (q + 1) + (xcd - r) * q) + off; }
        const int nig = WGM * nN, gid = wgid / nig, fm = gid * WGM, gsz = (nM - fm) < WGM ? (nM - fm) : WGM;
        u.pm = fm + ((wgid % nig) % gsz); u.pn = (wgid % nig) / gsz; return true;
    }
};

template <class F> struct Epi8 {
    static constexpr bool PERM = true;
    F f;
    __device__ __forceinline__ void operator()(const f32x4 (&acc)[2][2][4][2], const Unit& u, int wr, int wc, int fr, int fq) const {
        typename F::Ctx uc = f.unit(u);
#pragma unroll
        for (int bj = 0; bj < 2; ++bj) {
            const int col = u.pn * BM + bj * HALF + wc * 32 + 8 * fq;
            typename F::Col cc = f.col8(uc, col);
#pragma unroll
            for (int ai = 0; ai < 2; ++ai)
#pragma unroll
                for (int m = 0; m < 4; ++m) { const int row = u.pm * BM + ai * HALF + wr * 64 + m * 16 + fr; f.put8(uc, cc, row, col, acc[ai][bj][m][0], acc[ai][bj][m][1]); asm volatile("" ::: "memory"); }
        }
    }
};
template <class F> struct Epi4 {
    static constexpr bool PERM = false;
    F f;
    __device__ __forceinline__ void operator()(const f32x4 (&acc)[2][2][4][2], const Unit& u, int wr, int wc, int fr, int fq) const {
        typename F::Ctx uc = f.unit(u);
#pragma unroll
        for (int bj = 0; bj < 2; ++bj)
#pragma unroll
            for (int n = 0; n < 2; ++n) {
                const int col = u.pn * BM + bj * HALF + wc * 32 + 16 * n + 4 * fq;
                typename F::Col cc = f.col4(uc, col);
#pragma unroll
                for (int ai = 0; ai < 2; ++ai)
#pragma unroll
                    for (int m = 0; m < 4; ++m) { const int row = u.pm * BM + ai * HALF + wr * 64 + m * 16 + fr; f.put4(uc, cc, row, col, acc[ai][bj][m][n]); if (m & 1) asm volatile("" ::: "memory"); }
            }
    }
};

template <class Epi, class Sched, bool ALIGN_EPI>
__device__ __forceinline__ void gemm_phase(LAS unsigned char* lds, const Gemm g, const Sched& S, const Epi& E) {
    const int tid = otid(), wid = __builtin_amdgcn_readfirstlane(tid >> 6), lane = tid & 63, wr = wid >> 2, wc = wid & 3, fr = lane & 15, fq = lane >> 4;
    const int K = g.K, nt = K / BK, lda = g.lda;
    unsigned voffA[2], voffB[2];
#pragma unroll
    for (int i = 0; i < 2; ++i) { int R, C; stage_rc(tid * 16 + i * 8192, R, C); const int Rb = Epi::PERM ? ((R & ~31) + perm32(R & 31)) : R;
        voffA[i] = (unsigned)(R * lda + C) * 2u; voffB[i] = (unsigned)(Rb * K + C) * 2u; }
    const size_t kstep = (size_t)(BK * 2);
    const size_t hA = (size_t)HALF * lda * 2, tA = 2 * hA;
    const size_t hB = (size_t)HALF * K * 2, tB = 2 * hB;
    const unsigned ldsw = (unsigned)wid * 1024u;
    const int aoff = lds_byte(wr * 64 + fr, fq * 8), boff = lds_byte(wc * 32 + fr, fq * 8);
#define PG8_SA(b, h) (((b) * 2 + (h)) * HTB)
#define PG8_SB(b, h) ((4 + (b) * 2 + (h)) * HTB)
#define PG8_STAGE(bufoff, gbase, voff) do { _Pragma("unroll") for (int _i = 0; _i < 2; ++_i) \
        __builtin_amdgcn_global_load_lds((const unsigned*)((const char*)(gbase) + (voff)[_i]), (LAS unsigned*)(lds + (bufoff) + ldsw + _i * 8192), 16, 0, 0); } while (0)
#define PG8_LDA(dst, b, h) do { _Pragma("unroll") for (int m = 0; m < 4; ++m) _Pragma("unroll") for (int k = 0; k < 2; ++k) dst[m][k] = *(const LAS bf16x8*)(lds + PG8_SA(b, h) + aoff + m * 2048 + k * 1024); } while (0)
#define PG8_LDB(dst, b, h) do { _Pragma("unroll") for (int n = 0; n < 2; ++n) _Pragma("unroll") for (int k = 0; k < 2; ++k) dst[n][k] = *(const LAS bf16x8*)(lds + PG8_SB(b, h) + boff + n * 2048 + k * 1024); } while (0)
#define PG8_MMA(ai, bj, At, Bt) do { __builtin_amdgcn_s_setprio(1); _Pragma("unroll") for (int m = 0; m < 4; ++m) _Pragma("unroll") for (int n = 0; n < 2; ++n) _Pragma("unroll") for (int k = 0; k < 2; ++k) \
        acc[ai][bj][m][n] = __builtin_amdgcn_mfma_f32_16x16x32_bf16(Bt[n][k], At[m][k], acc[ai][bj][m][n], 0, 0, 0); __builtin_amdgcn_s_setprio(0); } while (0)
#define PG8_WAIT_V(n) asm volatile("s_waitcnt vmcnt(" #n ")" ::: "memory")
#define PG8_WAIT_L(n) asm volatile("s_waitcnt lgkmcnt(" #n ")" ::: "memory")
#define PG8_BAR __builtin_amdgcn_s_barrier()
#define PG8_SCHED __builtin_amdgcn_sched_barrier(0)
    Unit cur, nxt; int ui = 0;
    if (!S.next(0, cur)) return;
    f32x4 acc[2][2][4][2];
#pragma unroll
    for (int a = 0; a < 2; ++a)
#pragma unroll
        for (int b = 0; b < 2; ++b)
#pragma unroll
            for (int m = 0; m < 4; ++m)
#pragma unroll
                for (int n = 0; n < 2; ++n) acc[a][b][m][n] = (f32x4){0.f, 0.f, 0.f, 0.f};
    bf16x8 At[4][2], B0[2][2], B1[2][2];
    const char* cA = (const char*)g.A + (size_t)cur.pm * tA; const char* cB = (const char*)g.Bt + (size_t)cur.pn * tB;
    PG8_STAGE(PG8_SB(0, 0), cB, voffB); PG8_STAGE(PG8_SB(0, 1), cB + hB, voffB); PG8_STAGE(PG8_SA(0, 0), cA, voffA); PG8_STAGE(PG8_SA(0, 1), cA + hA, voffA);
    if (wr == 1) PG8_BAR;
    PG8_WAIT_V(2); PG8_BAR;
    PG8_STAGE(PG8_SB(1, 0), cB + kstep, voffB); PG8_STAGE(PG8_SA(1, 0), cA + kstep, voffA); PG8_STAGE(PG8_SB(1, 1), cB + hB + kstep, voffB);
    PG8_WAIT_V(6); PG8_BAR;
    for (;;) {
        const bool has_next = S.next(ui + 1, nxt);
        const char* nA = has_next ? (const char*)g.A + (size_t)nxt.pm * tA : cA; const char* nB = has_next ? (const char*)g.Bt + (size_t)nxt.pn * tB : cB;
#pragma unroll 1
        for (int t = 0; t < nt; t += 2) {
            const bool last = (t == nt - 2);
            const char* a1 = cA + (size_t)(t + 1) * kstep;
            const char* a2 = last ? nA : cA + (size_t)(t + 2) * kstep; const char* b2 = last ? nB : cB + (size_t)(t + 2) * kstep;
            const char* a3 = a2 + kstep; const char* b3 = b2 + kstep;
            PG8_LDB(B0, 0, 0); PG8_LDB(B1, 0, 1); PG8_SCHED; PG8_LDA(At, 0, 0); PG8_STAGE(PG8_SA(1, 1), a1 + hA, voffA);
            PG8_WAIT_V(8); PG8_WAIT_L(0); PG8_BAR; PG8_MMA(0, 0, At, B0); PG8_MMA(0, 1, At, B1); PG8_BAR; PG8_SCHED;
            PG8_LDA(At, 0, 1); PG8_STAGE(PG8_SB(0, 0), b2, voffB); PG8_STAGE(PG8_SB(0, 1), b2 + hB, voffB); PG8_STAGE(PG8_SA(0, 0), a2, voffA);
            PG8_WAIT_V(8); PG8_WAIT_L(0); PG8_BAR; PG8_MMA(1, 0, At, B0); PG8_MMA(1, 1, At, B1); PG8_BAR; PG8_SCHED;
            PG8_LDB(B0, 1, 0); PG8_LDB(B1, 1, 1); PG8_SCHED; PG8_LDA(At, 1, 0); PG8_STAGE(PG8_SA(0, 1), a2 + hA, voffA);
            PG8_WAIT_V(8); PG8_WAIT_L(0); PG8_BAR; PG8_MMA(0, 0, At, B0); PG8_MMA(0, 1, At, B1); PG8_BAR; PG8_SCHED;
            PG8_LDA(At, 1, 1); PG8_STAGE(PG8_SB(1, 0), b3, voffB); PG8_STAGE(PG8_SB(1, 1), b3 + hB, voffB); PG8_STAGE(PG8_SA(1, 0), a3, voffA);
            PG8_WAIT_V(8); PG8_WAIT_L(0); PG8_BAR; PG8_MMA(1, 0, At, B0); PG8_MMA(1, 1, At, B1); PG8_BAR; PG8_SCHED;
        }
        if constexpr (ALIGN_EPI) { if (wr == 0) PG8_BAR; }
        E(acc, cur, wr, wc, fr, fq);
        if (!has_next) break;
#pragma unroll
        for (int a = 0; a < 2; ++a)
#pragma unroll
            for (int b = 0; b < 2; ++b)
#pragma unroll
                for (int m = 0; m < 4; ++m)
#pragma unroll
                    for (int n = 0; n < 2; ++n) acc[a][b][m][n] = (f32x4){0.f, 0.f, 0.f, 0.f};
        cur = nxt; cA = nA; cB = nB; ++ui;
        if constexpr (ALIGN_EPI) { if (wr == 1) PG8_BAR; }
    }
    PG8_WAIT_V(0);
    if constexpr (!ALIGN_EPI) { if (wr == 0) PG8_BAR; }
    PG8_BAR;
#undef PG8_SA
#undef PG8_SB
#undef PG8_STAGE
#undef PG8_LDA
#undef PG8_LDB
#undef PG8_MMA
#undef PG8_WAIT_V
#undef PG8_WAIT_L
#undef PG8_BAR
#undef PG8_SCHED
}
}
typedef GAS unsigned gu32;
#define RLX_AGENT __ATOMIC_RELAXED, __HIP_MEMORY_SCOPE_AGENT
#define XB_TMO      128
#define XB_XCNT(j)  (256  + 64 * (j))
#define XB_XSUB(j)  (1280 + 64 * (j))
#define XB_XGEN(j)  (2304 + 64 * (j))
#define XB_TOP      3328
#define XB_TOPGEN   3392
#define XCD_BAR_WORDS 3456
#define XB_SPIN_CAP (1u << 18)
constexpr int CW_BAR = 4096;

__device__ __forceinline__ unsigned xb_ld(unsigned* p)              { return __hip_atomic_load(p, __ATOMIC_RELAXED, __HIP_MEMORY_SCOPE_AGENT); }
__device__ __forceinline__ unsigned xb_add(unsigned* p, unsigned v) { return __hip_atomic_fetch_add(p, v, __ATOMIC_RELAXED, __HIP_MEMORY_SCOPE_AGENT); }
__device__ __forceinline__ unsigned xb_xcc_id() { return (unsigned)__builtin_amdgcn_s_getreg((3 << 11) | 20) & 0xFu; }
#define XB_SPIN(cond, bar) do { unsigned _sp = 0; while (cond) { __builtin_amdgcn_s_sleep(1); \
    if ((++_sp & 255u) == 0u) { if (xb_ld(&(bar)[XB_TMO])) break; if (_sp > XB_SPIN_CAP) { atomicAdd(&(bar)[XB_TMO], 1u); break; } } } } while (0)

struct XcdBarrier { unsigned* bar; unsigned x; volatile LAS unsigned* st; };

__device__ __forceinline__ XcdBarrier xcd_barrier_post(unsigned* bar, volatile LAS unsigned* st) {
    XcdBarrier b; b.bar = bar; b.x = xb_xcc_id(); b.st = st;
    if (threadIdx.x == 0) (void)xb_add(&bar[XB_XCNT(b.x)], 1u);
    return b;
}
__device__ __forceinline__ void xcd_barrier_complete(unsigned* bar, unsigned x, unsigned& nloc, unsigned& nx) {
    const unsigned G = gridDim.x * gridDim.y * gridDim.z;
    unsigned sum, cnt, mine, sp = 0u;
    for (;;) {
        sum = 0u; cnt = 0u; mine = 0u;
#pragma unroll
        for (unsigned j = 0; j < 16; ++j) { const unsigned c = xb_ld(&bar[XB_XCNT(j)]); sum += c; cnt += (c > 0u) ? 1u : 0u; mine = (j == x) ? c : mine; }
        if (sum == G) break;
        __builtin_amdgcn_s_sleep(1);
        if ((++sp & 255u) == 0u) { if (xb_ld(&bar[XB_TMO])) break; if (sp > XB_SPIN_CAP) { atomicAdd(&bar[XB_TMO], 1u); break; } }
    }
    nloc = mine > 0u ? mine : 1u; nx = cnt > 0u ? cnt : 1u;
}
__device__ __forceinline__ void xcd_barrier(const XcdBarrier& b) {
    asm volatile("s_waitcnt vmcnt(0)" ::: "memory");
    __syncthreads();
    if (threadIdx.x == 0) {
        unsigned* bar = b.bar;
        __builtin_amdgcn_s_waitcnt(0);
        unsigned nloc = b.st[0], nx = b.st[1];
        if (nloc == 0u) { xcd_barrier_complete(bar, b.x, nloc, nx); b.st[0] = nloc; b.st[1] = nx; }
        const unsigned old = xb_add(&bar[XB_XSUB(b.x)], 1u);
        const unsigned gen = old / nloc;
        if (old + 1u == (gen + 1u) * nloc) {
            __builtin_amdgcn_fence(__ATOMIC_RELEASE, "agent");
            asm volatile("s_waitcnt vmcnt(0)" ::: "memory");
            const unsigned og = xb_add(&bar[XB_TOP], 1u);
            const unsigned tg = og / nx;
            if (og + 1u == (tg + 1u) * nx) xb_add(&bar[XB_TOPGEN], 1u);
            else XB_SPIN(xb_ld(&bar[XB_TOPGEN]) == tg, bar);
            __builtin_amdgcn_fence(__ATOMIC_ACQUIRE, "agent");
            xb_add(&bar[XB_XGEN(b.x)], 1u);
            asm volatile("s_waitcnt vmcnt(0)" ::: "memory");
        } else {
            XB_SPIN(xb_ld(&bar[XB_XGEN(b.x)]) == gen, bar);
            __builtin_amdgcn_fence(__ATOMIC_ACQUIRE, "agent");
            asm volatile("s_waitcnt vmcnt(0)" ::: "memory");
        }
    }
    __syncthreads();
}

constexpr int NWAVES = 8;
struct Frame {
    LAS unsigned char* lds;
    int tid, lane, wave, vcu, G;
    float* out; unsigned char* ws;
};
struct Args { const float* in[26]; float* out; unsigned char* ws; int ph_lo, ph_hi; };
__device__ __forceinline__ void refresh(Frame& F) { F.tid = otid(); F.lane = F.tid & 63; F.wave = __builtin_amdgcn_readfirstlane(F.tid >> 6); }
enum { I_X = 0, I_C, I_CTX, I_CCTX, I_WADA, I_BADA, I_WIN, I_GQN, I_WUQ, I_GKVN, I_WUKV, I_CONVW, I_CONVB, I_CLNG, I_CLNB, I_BGATES, I_MLG, I_WOUT, I_LN1G, I_LN1B, I_W1, I_B1, I_W2, I_B2, I_LN2G, I_LN2B };

__device__ __forceinline__ const float* modp(const Frame& F, int layer, int r, int chunk) { return (const float*)(F.ws + WS_MOD) + ((size_t)(layer * 17 + r) * 6 + chunk) * DM; }
__device__ __forceinline__ bf16_t* wptr(const Frame& F, int layer, size_t off) { return (bf16_t*)(F.ws + WS_W + (size_t)layer * W_LAYER + off); }

__device__ __forceinline__ int rope_src(int p) { const int g = p >> 4, q = p & 15; return g * 16 + (q & 1) * 8 + (q >> 1); }
__device__ __forceinline__ void tr_item(const float* W, int ldw, int n_valid, bf16_t* WT, int ldt, int row_off, int k_off, LAS float* scr, int kb, int nb, int lane,
                                        const float* gk, float cs, bool rope) {
    const int k0 = 64 * kb, n0 = 32 * nb;
#pragma unroll 8
    for (int i = 0; i < 32; ++i) { const int kk = 2 * i + (lane >> 5), n = n0 + (lane & 31);
        float v = (n < n_valid) ? W[(size_t)(k0 + kk) * ldw + n] : 0.f; if (gk) v *= gk[k0 + kk]; scr[kk * 33 + (lane & 31)] = v * cs; }
    LDS_WAIT(); asm volatile("" ::: "memory");
    const int c = lane & 7;
#pragma unroll
    for (int j = 0; j < 4; ++j) { const int n = (lane >> 3) + 8 * j; const int ns = rope ? rope_src(n) : n; const LAS float* s = scr + (8 * c) * 33 + ns;
        u32x4 o; o.x = pk2(s[0 * 33], s[1 * 33]); o.y = pk2(s[2 * 33], s[3 * 33]); o.z = pk2(s[4 * 33], s[5 * 33]); o.w = pk2(s[6 * 33], s[7 * 33]);
        *(GAS u32x4*)(WT + (size_t)(row_off + n0 + n) * ldt + k_off + k0 + 8 * c) = o; }
    LDS_WAIT(); asm volatile("" ::: "memory");
}
__device__ __forceinline__ void p0_prologue(Frame& F, const Args& A) {
    refresh(F);
    LAS float* scr = (LAS float*)(F.lds + F.wave * 16384);
    const int gw = F.vcu * NWAVES + F.wave, NGW = F.G * NWAVES;
    constexpr int I_IN = 16 * 64, I_UQ = 4 * 24, I_UKV = 2 * 32, I_OUT = 16 * 32, I_1 = 16 * 128, I_2 = 64 * 32, I_LAYER = I_IN + I_UQ + I_UKV + I_OUT + I_1 + I_2;
    for (int it = gw; it < DEPTH * I_LAYER; it += NGW) {
        const int l = it / I_LAYER; int r = it % I_LAYER;
        if (r < I_IN) { const int kb = r / 64, nb = r % 64;
            tr_item(A.in[I_WIN] + (size_t)l * DM * IN_COLS, IN_COLS, IN_COLS, wptr(F, l, W_IN), DM, 0, 0, scr, kb, nb, F.lane, nullptr, (nb >= 37 && nb < 45) ? 0.125f : 1.f, false); continue; }
        r -= I_IN;
        if (r < I_UQ) { const int kb = r / 24, nb = r % 24;
            tr_item(A.in[I_WUQ] + (size_t)l * 256 * 768, 768, 768, wptr(F, l, W_UP), KUP, 0, 0, scr, kb, nb, F.lane, A.in[I_GQN] + l * 256, 1.f, (nb % 3) == 2); continue; }
        r -= I_UQ;
        if (r < I_UKV) { const int kb = r / 32, nb = r % 32;
            tr_item(A.in[I_WUKV] + (size_t)l * 128 * 1024, 1024, 1024, wptr(F, l, W_UP), KUP, 768, 256, scr, kb, nb, F.lane, A.in[I_GKVN] + l * 128, 1.f, false); continue; }
        r -= I_UKV;
        if (r < I_OUT) { const int kb = r / 32, nb = r % 32;
            tr_item(A.in[I_WOUT] + (size_t)l * DM * DM, DM, DM, wptr(F, l, W_OUT), DM, 0, 0, scr, kb, nb, F.lane, nullptr, 1.f, false); continue; }
        r -= I_OUT;
        if (r < I_1) { const int kb = r / 128, nb = r % 128;
            tr_item(A.in[I_W1] + (size_t)l * DM * DFF, DFF, DFF, wptr(F, l, W_1), DM, 0, 0, scr, kb, nb, F.lane, nullptr, 1.f, false); continue; }
        r -= I_1;
        { const int kb = r / 32, nb = r % 32;
            tr_item(A.in[I_W2] + (size_t)l * DFF * DM, DM, DM, wptr(F, l, W_2), DFF, 0, 0, scr, kb, nb, F.lane, nullptr, 1.f, false); }
    }
    {
        const int gt = F.vcu * (NWAVES * 64) + F.tid, NGT = F.G * NWAVES * 64;
        constexpr int ZA = 768 * 16, ZB = 1024 * 32;
        for (int i = gt; i < DEPTH * (ZA + ZB); i += NGT) { const int l = i / (ZA + ZB); int r = i % (ZA + ZB); bf16_t* w = wptr(F, l, W_UP);
            if (r < ZA) *(GAS u32x4*)(w + (size_t)(r / 16) * KUP + 256 + (r % 16) * 8) = (u32x4){0u, 0u, 0u, 0u};
            else { r -= ZA; *(GAS u32x4*)(w + (size_t)(768 + r / 32) * KUP + (r % 32) * 8) = (u32x4){0u, 0u, 0u, 0u}; } }
        for (int i = gt; i < SEQ * 16; i += NGT) { const int l = i >> 4, j = i & 15, g = j >> 3, ii = j & 7;
            double f = (ii & 1) ? 0.31622776601683794 : 1.0;
            f *= ((ii >> 1) == 1) ? 0.1 : ((ii >> 1) == 2) ? 0.01 : ((ii >> 1) == 3) ? 0.001 : 1.0;
            const double pos = (double)(g == 0 ? (l >> 6) : (l & 63));
            double ang = pos * f; ang -= 6.283185307179586476925 * __builtin_rint(ang * 0.15915494309189533577);
            const float a = (float)ang; ((GAS f32x2*)(F.ws + WS_ROPE))[i] = (f32x2){cosf(a), sinf(a)}; }
    }
    __syncthreads();
    {
        LAS float* sc = (LAS float*)F.lds;
        LAS float* red = (LAS float*)(F.lds + 17 * 1024 * 4);
        bool have = false;
        for (int it = F.vcu; it < DEPTH * 96; it += F.G) {
            if (!have) { for (int i = F.tid; i < 17 * 1024; i += NWAVES * 64) { const float v = (i < 16 * 1024) ? A.in[I_C][i] : A.in[I_CCTX][i - 16 * 1024]; sc[i] = v / (1.f + __expf(-v)); } have = true; __syncthreads(); }
            const int l = it / 96, cb = it % 96, col = cb * 64 + F.lane;
            const float* w = A.in[I_WADA] + (size_t)l * DM * 6144 + col;
            float acc[17];
#pragma unroll
            for (int r = 0; r < 17; ++r) acc[r] = 0.f;
            const int k0 = F.wave * 128;
#pragma unroll 4
            for (int k = 0; k < 128; ++k) { const float wv = w[(size_t)(k0 + k) * 6144];
#pragma unroll
                for (int r = 0; r < 17; ++r) acc[r] += sc[r * 1024 + k0 + k] * wv; }
#pragma unroll
            for (int r = 0; r < 17; ++r) red[(F.wave * 17 + r) * 64 + F.lane] = acc[r];
            __syncthreads();
            for (int i = F.tid; i < 17 * 64; i += NWAVES * 64) { const int r = i >> 6, cl = i & 63; float s = 0.f;
#pragma unroll
                for (int wv = 0; wv < 8; ++wv) s += red[(wv * 17 + r) * 64 + cl];
                ((float*)(F.ws + WS_MOD))[((size_t)(l * 17 + r)) * 6144 + cb * 64 + cl] = s + A.in[I_BADA][l * 6144 + cb * 64 + cl]; }
            __syncthreads();
        }
    }
}

__device__ __forceinline__ void p1_xm(Frame& F, const Args& A) {
    refresh(F);
    const int gw = F.vcu * NWAVES + F.wave, NGW = F.G * NWAVES;
    bf16_t* xm = (bf16_t*)(F.ws + WS_XM);
    for (int m = gw; m < MT; m += NGW) {
        const float* src = m < ML ? A.in[I_X] + (size_t)m * DM : A.in[I_CTX] + (size_t)(m - ML) * DM; const int r = m < ML ? (m >> 11) : 16;
        const GAS f32x4* xr = (const GAS f32x4*)src + F.lane; const GAS f32x4* sh = (const GAS f32x4*)modp(F, 0, r, 0) + F.lane; const GAS f32x4* sc = (const GAS f32x4*)modp(F, 0, r, 1) + F.lane;
        GAS u32x2* o8 = (GAS u32x2*)(xm + (size_t)m * DM) + F.lane;
#pragma unroll
        for (int j = 0; j < 4; ++j) { const f32x4 v = xr[64 * j], a = sc[64 * j], b = sh[64 * j]; const f32x4 o = v * (1.f + a) + b; o8[64 * j] = (u32x2){pk2(o.x, o.y), pk2(o.z, o.w)}; }
    }
}
__device__ __forceinline__ void ln_pass(Frame& F, const Args& A, int M, const float* gam, const float* bet, bool do_xm, int lm, int csh, int csc) {
    refresh(F);
    const int gw = F.vcu * NWAVES + F.wave, NGW = F.G * NWAVES;
    bf16_t* xm = (bf16_t*)(F.ws + WS_XM);
    for (int m = gw; m < M; m += NGW) {
        float* row = m < ML ? F.out + (size_t)m * DM : (float*)(F.ws + WS_CTXF) + (size_t)(m - ML) * DM; const int r = m < ML ? (m >> 11) : 16;
        GAS f32x4* xr = (GAS f32x4*)row + F.lane;
        f32x4 v[4]; float s = 0.f;
#pragma unroll
        for (int j = 0; j < 4; ++j) { v[j] = xr[64 * j]; s += (v[j].x + v[j].y) + (v[j].z + v[j].w); }
        const float mean = wave_sum(s) * (1.f / DM); float s2 = 0.f;
#pragma unroll
        for (int j = 0; j < 4; ++j) { v[j] = v[j] - mean; s2 += (v[j].x * v[j].x + v[j].y * v[j].y) + (v[j].z * v[j].z + v[j].w * v[j].w); }
        const float rstd = 1.f / sqrtf(wave_sum(s2) * (1.f / DM) + LN_EPS);
        const GAS f32x4* g4 = (const GAS f32x4*)gam + F.lane; const GAS f32x4* b4 = (const GAS f32x4*)bet + F.lane;
#pragma unroll
        for (int j = 0; j < 4; ++j) { v[j] = v[j] * rstd * g4[64 * j] + b4[64 * j]; xr[64 * j] = v[j]; }
        if (do_xm) {
            const GAS f32x4* sh = (const GAS f32x4*)modp(F, lm, r, csh) + F.lane; const GAS f32x4* sc = (const GAS f32x4*)modp(F, lm, r, csc) + F.lane;
            GAS u32x2* o8 = (GAS u32x2*)(xm + (size_t)m * DM) + F.lane;
#pragma unroll
            for (int j = 0; j < 4; ++j) { const f32x4 o = v[j] * (1.f + sc[64 * j]) + sh[64 * j]; o8[64 * j] = (u32x2){pk2(o.x, o.y), pk2(o.z, o.w)}; }
        }
    }
}
struct NoCtx {};
struct FInProj {
    typedef NoCtx Ctx; typedef NoCtx Col;
    bf16_t* P; float* gate;
    __device__ __forceinline__ Ctx unit(const pg8::Unit&) const { return Ctx(); }
    __device__ __forceinline__ Col col8(const Ctx&, int) const { return Col(); }
    __device__ __forceinline__ void put8(const Ctx&, const Col&, int row, int col, f32x4 v0, f32x4 v1) const {
        *(GAS u32x4*)(P + (size_t)row * NP + col) = (u32x4){pk2(v0.x, v0.y), pk2(v0.z, v0.w), pk2(v1.x, v1.y), pk2(v1.z, v1.w)};
        if (col == C_MG || col == C_MG + 8) { GAS f32x4* g = (GAS f32x4*)(gate + (size_t)row * 16 + (col - C_MG)); g[0] = v0; g[1] = v1; }
    }
};
struct EpiUp {
    static constexpr bool PERM = true;
    unsigned char* ws;
    __device__ __forceinline__ void operator()(const f32x4 (&acc)[2][2][4][2], const pg8::Unit& u, int wr, int wc, int fr, int fq) const {
        bf16_t* const Q = (bf16_t*)(ws + WS_Q); bf16_t* const QC = (bf16_t*)(ws + WS_QC); bf16_t* const Kb = (bf16_t*)(ws + WS_K); bf16_t* const Vb = (bf16_t*)(ws + WS_V);
        const float* const rs = (const float*)(ws + WS_RS); const f32x2* const rope = (const f32x2*)(ws + WS_ROPE);
        const bool lat = u.pm < ML / 256;
        const int b = lat ? (u.pm >> 3) : (u.pm - ML / 256), l0 = lat ? (u.pm & 7) * 256 : 0;
        if (u.pn < 3) {
            const int Lr = lat ? SEQ : CTXL; bf16_t* base = lat ? Q : QC;
#pragma unroll
            for (int bj = 0; bj < 2; ++bj) {
                const int col = u.pn * 256 + bj * 128 + wc * 32 + 8 * fq, h = col / 96, d = col - h * 96;
                const bool dorope = lat && d >= 64; const int p = d - 64, j0 = (p >> 4) * 8 + ((p & 15) >> 1);
                bf16_t* cb = base + (size_t)(b * NHEAD + h) * Lr * 96 + d;
#pragma unroll
                for (int ai = 0; ai < 2; ++ai)
#pragma unroll
                    for (int m = 0; m < 4; ++m) { const int lr = ai * 128 + wr * 64 + m * 16 + fr, l = l0 + lr; const int row = u.pm * 256 + lr;
                        const float s = rs[(size_t)row * 2] * QSCALE; f32x4 v0 = acc[ai][bj][m][0], v1 = acc[ai][bj][m][1];
                        if (dorope) { const f32x2* t = rope + (size_t)l * 16 + j0; const f32x2 c0 = t[0], c1 = t[1], c2 = t[2], c3 = t[3]; const f32x4 a = v0, q = v1;
                            v0.x = a.x * c0.x - a.y * c0.y; v0.y = a.x * c0.y + a.y * c0.x; v0.z = a.z * c1.x - a.w * c1.y; v0.w = a.z * c1.y + a.w * c1.x;
                            v1.x = q.x * c2.x - q.y * c2.y; v1.y = q.x * c2.y + q.y * c2.x; v1.z = q.z * c3.x - q.w * c3.y; v1.w = q.z * c3.y + q.w * c3.x; }
                        v0 = v0 * s; v1 = v1 * s;
                        *(GAS u32x4*)(cb + (size_t)l * 96) = (u32x4){pk2(v0.x, v0.y), pk2(v0.z, v0.w), pk2(v1.x, v1.y), pk2(v1.z, v1.w)};
                        asm volatile("" ::: "memory"); }
            }
        } else {
            const int lk0 = lat ? l0 : SEQ; const bool isv = wc >= 2; const int d = (wc & 1) * 32 + 8 * fq, pitch = isv ? 64 : 96;
#pragma unroll
            for (int bj = 0; bj < 2; ++bj) {
                const int h = (u.pn - 3) * 2 + bj;
                bf16_t* cb = (isv ? Vb : Kb) + (size_t)(b * NHEAD + h) * LKV * pitch + d;
#pragma unroll
                for (int ai = 0; ai < 2; ++ai)
#pragma unroll
                    for (int m = 0; m < 4; ++m) { const int lr = ai * 128 + wr * 64 + m * 16 + fr; const int row = u.pm * 256 + lr;
                        const float s = rs[(size_t)row * 2 + 1]; const f32x4 v0 = acc[ai][bj][m][0] * s, v1 = acc[ai][bj][m][1] * s;
                        *(GAS u32x4*)(cb + (size_t)(lk0 + lr) * pitch) = (u32x4){pk2(v0.x, v0.y), pk2(v0.z, v0.w), pk2(v1.x, v1.y), pk2(v1.z, v1.w)};
                        asm volatile("" ::: "memory"); }
            }
        }
    }
};
struct FRes {
    struct Ctx { const float* res; float* dst; const float* gv; const float* bias; };
    struct Col { f32x4 g, b; };
    const float* xlat; const float* xctx; float* olat; float* octx; const float* gmod; const float* bias;
    __device__ __forceinline__ Ctx unit(const pg8::Unit& u) const {
        Ctx c; const bool lat = u.pm < ML / 256; const int r = lat ? (u.pm >> 3) : 16;
        c.res = lat ? xlat : xctx - (size_t)ML * DM; c.dst = lat ? olat : octx - (size_t)ML * DM; c.gv = gmod + (size_t)r * 6144; c.bias = bias; return c; }
    __device__ __forceinline__ Col col4(const Ctx& c, int col) const { Col k; k.g = *(const GAS f32x4*)(c.gv + col); k.b = c.bias ? *(const GAS f32x4*)(c.bias + col) : (f32x4){0.f, 0.f, 0.f, 0.f}; return k; }
    __device__ __forceinline__ void put4(const Ctx& c, const Col& k, int row, int col, f32x4 v) const {
        const f32x4 x = *(const GAS f32x4*)(c.res + (size_t)row * DM + col);
        *(GAS f32x4*)(c.dst + (size_t)row * DM + col) = x * DN_ALPHA + k.g * (v + k.b);
    }
};
struct FMlp1 {
    typedef NoCtx Ctx; struct Col { f32x4 b0, b1; };
    bf16_t* H; const float* b1;
    __device__ __forceinline__ Ctx unit(const pg8::Unit&) const { return Ctx(); }
    __device__ __forceinline__ Col col8(const Ctx&, int col) const { Col k; k.b0 = *(const GAS f32x4*)(b1 + col); k.b1 = *(const GAS f32x4*)(b1 + col + 4); return k; }
    __device__ __forceinline__ void put8(const Ctx&, const Col& k, int row, int col, f32x4 v0, f32x4 v1) const {
        f32x4 a = v0 + k.b0, b = v1 + k.b1;
        a.x = fmaxf(a.x, 0.f); a.y = fmaxf(a.y, 0.f); a.z = fmaxf(a.z, 0.f); a.w = fmaxf(a.w, 0.f); b.x = fmaxf(b.x, 0.f); b.y = fmaxf(b.y, 0.f); b.z = fmaxf(b.z, 0.f); b.w = fmaxf(b.w, 0.f);
        a = a * a; b = b * b;
        *(GAS u32x4*)(H + (size_t)row * DFF + col) = (u32x4){pk2(a.x, a.y), pk2(a.z, a.w), pk2(b.x, b.y), pk2(b.z, b.w)};
    }
};

__device__ __forceinline__ void pb_rows(Frame& F, const Args& A) {
    refresh(F);
    const int gw = F.vcu * NWAVES + F.wave, NGW = F.G * NWAVES; const int lane = F.lane;
    const bf16_t* P = (const bf16_t*)(F.ws + WS_P); float* rs = (float*)(F.ws + WS_RS); bf16_t* Kb = (bf16_t*)(F.ws + WS_K); const f32x2* rope = (const f32x2*)(F.ws + WS_ROPE);
    for (int m = gw; m < MT; m += NGW) {
        const bf16_t* prow = P + (size_t)m * NP;
        float ss = 0.f;
        if (lane < 48) { const u32x4 w = *(const GAS u32x4*)(prow + lane * 8); const float a0 = bflo(w.x), a1 = bfhi(w.x), a2 = bflo(w.y), a3 = bfhi(w.y), a4 = bflo(w.z), a5 = bfhi(w.z), a6 = bflo(w.w), a7 = bfhi(w.w);
            ss = (a0 * a0 + a1 * a1) + (a2 * a2 + a3 * a3) + (a4 * a4 + a5 * a5) + (a6 * a6 + a7 * a7); }
        const float sq = wave_sum(lane < 32 ? ss : 0.f), skv = wave_sum(lane >= 32 ? ss : 0.f);
        if (lane == 0) { rs[(size_t)m * 2] = 1.f / sqrtf(sq * (1.f / 256.f) + RMS_EPS); rs[(size_t)m * 2 + 1] = 1.f / sqrtf(skv * (1.f / 128.f) + RMS_EPS); }
        if (lane < 32) {
            const int p = lane, g = p >> 4, q = p & 15, i = q >> 1, which = q & 1;
            const float x1 = bf2f(prow[C_KR + g * 16 + i]), x2 = bf2f(prow[C_KR + g * 16 + 8 + i]);
            const bool lat = m < ML; const int rc = m - ML; const int b = lat ? (m >> 11) : (rc >> 8), l = lat ? (m & 2047) : (rc & 255);
            float o;
            if (lat) { const f32x2 cs = rope[(size_t)l * 16 + g * 8 + i]; o = which ? x1 * cs.y + x2 * cs.x : x1 * cs.x - x2 * cs.y; } else o = which ? x2 : x1;
            const bf16_t ob = (bf16_t)f2bf(o); const int lk = lat ? l : SEQ + l;
#pragma unroll
            for (int h = 0; h < NHEAD; ++h) Kb[((size_t)(b * NHEAD + h) * LKV + lk) * 96 + 64 + p] = ob;
        }
    }
}
__device__ __forceinline__ void conv_task(Frame& F, const Args& A, int layer, int b, int tb, bool isctx) {
    refresh(F);
    const int L = isctx ? CTXL : SEQ, rowbase = isctx ? ML + b * CTXL : b * SEQ, t0 = tb * 64, tid = F.tid;
    const bf16_t* P = (const bf16_t*)(F.ws + WS_P); bf16_t* mix = (bf16_t*)(F.ws + WS_MIX);
    LAS bf16_t* zb = (LAS bf16_t*)F.lds;
    LAS float* ob = (LAS float*)(F.lds + 94 * 256 * 2);
    for (int idx = tid; idx < 94 * 32; idx += NWAVES * 64) { const int r = idx >> 5, c8 = (idx & 31) * 8, t = t0 - 15 + r;
        u32x4 o = (u32x4){0u, 0u, 0u, 0u};
        if (t >= 0 && t < L) { const bf16_t* pr = P + (size_t)(rowbase + t) * NP; const u32x4 a = *(const GAS u32x4*)(pr + C_CA + c8), g = *(const GAS u32x4*)(pr + C_CG + c8);
            o.x = pk2(bflo(a.x) * sigmoidf_(bflo(g.x)), bfhi(a.x) * sigmoidf_(bfhi(g.x))); o.y = pk2(bflo(a.y) * sigmoidf_(bflo(g.y)), bfhi(a.y) * sigmoidf_(bfhi(g.y)));
            o.z = pk2(bflo(a.z) * sigmoidf_(bflo(g.z)), bfhi(a.z) * sigmoidf_(bfhi(g.z))); o.w = pk2(bflo(a.w) * sigmoidf_(bflo(g.w)), bfhi(a.w) * sigmoidf_(bfhi(g.w))); }
        *(LAS u32x4*)(zb + r * 256 + c8) = o; }
    __syncthreads();
    {
        const int ch = tid & 255, half = tid >> 8;
        const float* cw = A.in[I_CONVW] + (size_t)layer * 31 * 256 + ch; const float bias = A.in[I_CONVB][layer * 256 + ch];
        float w[31];
#pragma unroll
        for (int k = 0; k < 31; ++k) w[k] = cw[k * 256];
#pragma unroll 1
        for (int pass = 0; pass < 4; ++pass) { const int tl0 = half * 32 + pass * 8;
            float z[38];
#pragma unroll
            for (int i = 0; i < 38; ++i) z[i] = bf2f(zb[(tl0 + i) * 256 + ch]);
#pragma unroll
            for (int o = 0; o < 8; ++o) { float a = bias;
#pragma unroll
                for (int k = 0; k < 31; ++k) a += w[k] * z[o + k];
                ob[(tl0 + o) * 256 + ch] = a; } }
    }
    __syncthreads();
    {
        const float* lg = A.in[I_CLNG] + layer * 256; const float* lb = A.in[I_CLNB] + layer * 256; const int lane = F.lane;
        const f32x4 g4 = *(const GAS f32x4*)(lg + 4 * lane), b4 = *(const GAS f32x4*)(lb + 4 * lane);
#pragma unroll 2
        for (int i = 0; i < 8; ++i) { const int tl = F.wave * 8 + i; f32x4 v = *(LAS f32x4*)(ob + tl * 256 + 4 * lane);
            const float mean = wave_sum((v.x + v.y) + (v.z + v.w)) * (1.f / 256.f); v = v - mean;
            const float rstd = 1.f / sqrtf(wave_sum((v.x * v.x + v.y * v.y) + (v.z * v.z + v.w * v.w)) * (1.f / 256.f) + LN_EPS);
            v = v * rstd * g4 + b4;
            v.x = v.x * sigmoidf_(v.x); v.y = v.y * sigmoidf_(v.y); v.z = v.z * sigmoidf_(v.z); v.w = v.w * sigmoidf_(v.w);
            *(GAS u32x2*)(mix + (size_t)(rowbase + t0 + tl) * DM + 512 + 4 * lane) = (u32x2){pk2(v.x, v.y), pk2(v.z, v.w)}; }
    }
    __syncthreads();
}

__device__ __forceinline__ int chunk_row(int b, int ci) { return ci < 2 ? ML + b * CTXL + ci * 128 : b * SEQ + (ci - 2) * 128; }
__device__ __forceinline__ int scan_order(int dir, int j) { return dir == 0 ? j : (j == 0 ? 1 : (j == 1 ? 0 : 19 - j)); }
__device__ __forceinline__ void scan_add2(float& e0, float& e1, int lane) { e1 += e0; float s = e1;
#pragma unroll
    for (int o = 1; o < 64; o <<= 1) { const float t = __shfl_up(s, o); if (lane >= o) s += t; }
    const float ex = s - e1; e0 += ex; e1 += ex; }
__device__ __forceinline__ void scan_max2(float& e0, float& e1, int lane) { e1 = fmaxf(e1, e0); float s = e1;
#pragma unroll
    for (int o = 1; o < 64; o <<= 1) { const float t = __shfl_up(s, o); if (lane >= o) s = fmaxf(s, t); }
    float ex = __shfl_up(s, 1); if (lane == 0) ex = -INFINITY; e0 = fmaxf(e0, ex); e1 = fmaxf(e1, ex); }

__device__ __forceinline__ void mlstm_local_task(Frame& F, const Args& A, int layer, int b, int h, int ci) {
    refresh(F);
    const int tid = F.tid, lane = F.lane, wave = F.wave, row0 = chunk_row(b, ci);
    const bf16_t* P = (const bf16_t*)(F.ws + WS_P); const float* gate = (const float*)(F.ws + WS_GATE); const float* bg = A.in[I_BGATES] + layer * 16;
    bf16_t* Cst = (bf16_t*)(F.ws + WS_CST); float* Nst = (float*)(F.ws + WS_MN); float* Msc = (float*)(F.ws + WS_MSC);
    LAS bf16_t* KT = (LAS bf16_t*)F.lds;
    LAS bf16_t* VwT = (LAS bf16_t*)(F.lds + 64 * 136 * 2);
    LAS float* wv = (LAS float*)(F.lds + 3 * 64 * 136 * 2);
    if (wave < 2) { const int dir = wave; const int seq = (b * MLH + h) * 2 + dir;
        const int j0 = 2 * lane, s0 = dir ? 127 - j0 : j0, s1 = dir ? 126 - j0 : j0 + 1;
        const float li0 = gate[(size_t)(row0 + s0) * 16 + dir * 8 + h] + bg[dir * 8 + h], li1 = gate[(size_t)(row0 + s1) * 16 + dir * 8 + h] + bg[dir * 8 + h];
        float b0 = logsigmoidf_(gate[(size_t)(row0 + s0) * 16 + dir * 8 + 4 + h] + bg[dir * 8 + 4 + h]), b1 = logsigmoidf_(gate[(size_t)(row0 + s1) * 16 + dir * 8 + 4 + h] + bg[dir * 8 + 4 + h]);
        scan_add2(b0, b1, lane);
        const float btot = __shfl(b1, 63);
        const float g0 = btot - b0 + li0, g1 = btot - b1 + li1;
        const float mloc = wave_max(fmaxf(g0, g1));
        wv[dir * 128 + s0] = __expf(g0 - mloc); wv[dir * 128 + s1] = __expf(g1 - mloc);
        if (lane == 0) { Msc[(size_t)(seq * NCHUNK + ci) * 4] = mloc; Msc[(size_t)(seq * NCHUNK + ci) * 4 + 1] = btot; } }
    __syncthreads();
    { const int s = tid >> 2, d0 = (tid & 3) * 16; const bf16_t* pr = P + (size_t)(row0 + s) * NP + h * 64 + d0;
        const u32x4 ka = *(const GAS u32x4*)(pr + C_MK), kb = *(const GAS u32x4*)(pr + C_MK + 8), va = *(const GAS u32x4*)(pr + C_MV), vb = *(const GAS u32x4*)(pr + C_MV + 8);
        const unsigned kw[8] = {ka.x, ka.y, ka.z, ka.w, kb.x, kb.y, kb.z, kb.w}, vw[8] = {va.x, va.y, va.z, va.w, vb.x, vb.y, vb.z, vb.w};
        const float w0 = wv[s], w1 = wv[128 + s];
#pragma unroll
        for (int j = 0; j < 8; ++j) { KT[(d0 + 2 * j) * 136 + s] = (bf16_t)(kw[j] & 0xffffu); KT[(d0 + 2 * j + 1) * 136 + s] = (bf16_t)(kw[j] >> 16);
            const float v0 = bflo(vw[j]), v1 = bfhi(vw[j]);
            VwT[(d0 + 2 * j) * 136 + s] = (bf16_t)f2bf(v0 * w0); VwT[(d0 + 2 * j + 1) * 136 + s] = (bf16_t)f2bf(v1 * w0);
            VwT[(64 + d0 + 2 * j) * 136 + s] = (bf16_t)f2bf(v0 * w1); VwT[(64 + d0 + 2 * j + 1) * 136 + s] = (bf16_t)f2bf(v1 * w1); } }
    __syncthreads();
    { const int dir = wave >> 2, vi = (wave >> 1) & 1, ki = wave & 1, r32 = lane & 31, hh = lane >> 5; const int seq = (b * MLH + h) * 2 + dir;
        f32x16 acc = {};
#pragma unroll
        for (int ks = 0; ks < 8; ++ks) { const bf16x8 a = *(const LAS bf16x8*)(VwT + (dir * 64 + vi * 32 + r32) * 136 + ks * 16 + hh * 8), bb = *(const LAS bf16x8*)(KT + (ki * 32 + r32) * 136 + ks * 16 + hh * 8);
            acc = __builtin_amdgcn_mfma_f32_32x32x16_bf16(a, bb, acc, 0, 0, 0); }
        bf16_t* cdst = Cst + (size_t)(seq * NCHUNK + ci) * 4096;
#pragma unroll
        for (int r = 0; r < 16; ++r) cdst[(vi * 32 + crow(r, hh)) * 64 + ki * 32 + r32] = (bf16_t)f2bf(acc[r]); }
    if (tid < 128) { const int dir = tid >> 6, k = tid & 63; const int seq = (b * MLH + h) * 2 + dir; float n = 0.f;
        for (int s = 0; s < 128; ++s) n += wv[dir * 128 + s] * bf2f(KT[k * 136 + s]);
        Nst[(size_t)(seq * NCHUNK + ci) * 64 + k] = n; }
    __syncthreads();
}
__device__ __forceinline__ void mlstm_scan_task(Frame& F, int st) {
    refresh(F);
    const int seq = st >> 3, part = st & 7, dir = seq & 1, e = part * 512 + F.tid;
    bf16_t* Cst = (bf16_t*)(F.ws + WS_CST) + (size_t)seq * NCHUNK * 4096; float* Nst = (float*)(F.ws + WS_MN) + (size_t)seq * NCHUNK * 64; float* Msc = (float*)(F.ws + WS_MSC) + (size_t)seq * NCHUNK * 4;
    float m = 0.f, c = 0.f, n = 0.f; const bool don = (part == 0 && F.tid < 64);
    for (int j = 0; j < NCHUNK; ++j) { const int ci = scan_order(dir, j);
        const float mloc = Msc[ci * 4], bt = Msc[ci * 4 + 1];
        const float cl = bf2f(Cst[(size_t)ci * 4096 + e]); Cst[(size_t)ci * 4096 + e] = (bf16_t)f2bf(c);
        float nl = 0.f; if (don) { nl = Nst[ci * 64 + F.tid]; Nst[ci * 64 + F.tid] = n; }
        if (part == 0 && F.tid == 0) Msc[ci * 4 + 2] = m;
        const float mn = fmaxf(bt + m, mloc), fa = __expf(bt + m - mn), fb = __expf(mloc - mn);
        c = fa * c + fb * cl; n = fa * n + fb * nl; m = mn; }
}
__device__ __forceinline__ void mlstm_out_task(Frame& F, const Args& A, int layer, int b, int h, int ci) {
    refresh(F);
    const int tid = F.tid, lane = F.lane, wave = F.wave, row0 = chunk_row(b, ci), r32 = lane & 31, hh = lane >> 5;
    const bf16_t* P = (const bf16_t*)(F.ws + WS_P); const float* gate = (const float*)(F.ws + WS_GATE); const float* bg = A.in[I_BGATES] + layer * 16;
    const bf16_t* Cst = (const bf16_t*)(F.ws + WS_CST); const float* Nst = (const float*)(F.ws + WS_MN); const float* Msc = (const float*)(F.ws + WS_MSC); bf16_t* mix = (bf16_t*)(F.ws + WS_MIX);
    LAS bf16_t* Qs = (LAS bf16_t*)F.lds;
    LAS bf16_t* Ks = Qs + 128 * 72;
    LAS bf16_t* VT = Ks + 128 * 72;
    LAS bf16_t* Cs = VT + 64 * 136;
    LAS bf16_t* Sb = Cs + 64 * 72;
    LAS float* Hs = (LAS float*)(Sb + 128 * 136);
    LAS float* va = Hs + 128 * 65;
    LAS float* vM = va + 128, *vI = vM + 128, *vE = vI + 128, *vD = vE + 128, *vN = vD + 128;
    { const int s = tid >> 2, d0 = (tid & 3) * 16; const bf16_t* pr = P + (size_t)(row0 + s) * NP + h * 64 + d0;
        const u32x4 qa = *(const GAS u32x4*)(pr + C_MQ), qb = *(const GAS u32x4*)(pr + C_MQ + 8), ka = *(const GAS u32x4*)(pr + C_MK), kb = *(const GAS u32x4*)(pr + C_MK + 8), va4 = *(const GAS u32x4*)(pr + C_MV), vb4 = *(const GAS u32x4*)(pr + C_MV + 8);
        *(LAS u32x4*)(Qs + s * 72 + d0) = qa; *(LAS u32x4*)(Qs + s * 72 + d0 + 8) = qb; *(LAS u32x4*)(Ks + s * 72 + d0) = ka; *(LAS u32x4*)(Ks + s * 72 + d0 + 8) = kb;
        const unsigned vw[8] = {va4.x, va4.y, va4.z, va4.w, vb4.x, vb4.y, vb4.z, vb4.w};
#pragma unroll
        for (int j = 0; j < 8; ++j) { VT[(d0 + 2 * j) * 136 + s] = (bf16_t)(vw[j] & 0xffffu); VT[(d0 + 2 * j + 1) * 136 + s] = (bf16_t)(vw[j] >> 16); } }
#pragma unroll 1
    for (int dir = 0; dir < 2; ++dir) {
        const int seq = (b * MLH + h) * 2 + dir; const size_t sidx = (size_t)seq * NCHUNK + ci;
        const float m_in = Msc[sidx * 4 + 2];
        if (wave == 0) { const int j0 = 2 * lane, s0 = dir ? 127 - j0 : j0, s1 = dir ? 126 - j0 : j0 + 1;
            const float li0 = gate[(size_t)(row0 + s0) * 16 + dir * 8 + h] + bg[dir * 8 + h], li1 = gate[(size_t)(row0 + s1) * 16 + dir * 8 + h] + bg[dir * 8 + h];
            float b0 = logsigmoidf_(gate[(size_t)(row0 + s0) * 16 + dir * 8 + 4 + h] + bg[dir * 8 + 4 + h]), b1 = logsigmoidf_(gate[(size_t)(row0 + s1) * 16 + dir * 8 + 4 + h] + bg[dir * 8 + 4 + h]);
            scan_add2(b0, b1, lane);
            const float a0 = li0 - b0, a1 = li1 - b1; float M0 = a0, M1 = a1; scan_max2(M0, M1, lane); M0 = fmaxf(M0, m_in); M1 = fmaxf(M1, m_in);
            va[s0] = a0; va[s1] = a1; vM[s0] = M0; vM[s1] = M1; vI[s0] = __expf(m_in - M0); vI[s1] = __expf(m_in - M1); vE[s0] = __expf(-(b0 + M0)); vE[s1] = __expf(-(b1 + M1)); }
        else if (wave == 1) { vN[lane] = Nst[sidx * 64 + lane]; }
        { const u32x4 c = *(const GAS u32x4*)(Cst + sidx * 4096 + tid * 8); *(LAS u32x4*)(Cs + (tid >> 3) * 72 + (tid & 7) * 8) = c; }
        __syncthreads();
        { const int tb = wave >> 1;
#pragma unroll
            for (int q = 0; q < 2; ++q) { const int sb = (wave & 1) * 2 + q; f32x16 acc = {};
#pragma unroll
                for (int ks = 0; ks < 4; ++ks) { const bf16x8 a = *(const LAS bf16x8*)(Qs + (tb * 32 + r32) * 72 + ks * 16 + hh * 8), bb = *(const LAS bf16x8*)(Ks + (sb * 32 + r32) * 72 + ks * 16 + hh * 8);
                    acc = __builtin_amdgcn_mfma_f32_32x32x16_bf16(a, bb, acc, 0, 0, 0); }
                const int s = sb * 32 + r32; const float as = va[s];
#pragma unroll
                for (int r = 0; r < 16; ++r) { const int t = tb * 32 + crow(r, hh); const bool keep = dir ? (s >= t) : (s <= t);
                    const float w = keep ? __expf(as - vM[t]) : 0.f; Sb[t * 136 + s] = (bf16_t)f2bf(acc[r] * w); } } }
        __syncthreads();
        { const int t = tid >> 2, q = tid & 3; float ds = 0.f, nq = 0.f;
#pragma unroll 8
            for (int i = 0; i < 32; ++i) ds += bf2f(Sb[t * 136 + q * 32 + i]);
#pragma unroll
            for (int i = 0; i < 16; ++i) nq += vN[q * 16 + i] * bf2f(Qs[t * 72 + q * 16 + i]);
            ds += __shfl_xor(ds, 1); ds += __shfl_xor(ds, 2); nq += __shfl_xor(nq, 1); nq += __shfl_xor(nq, 2);
            if (q == 0) { const float den = ds + vI[t] * nq; vD[t] = 1.f / fmaxf(fabsf(den), vE[t]); } }
        f32x16 acc = {}, acc2 = {};
        { const int tb = wave >> 1, vb = wave & 1;
#pragma unroll
            for (int ks = 0; ks < 8; ++ks) { const bf16x8 a = *(const LAS bf16x8*)(Sb + (tb * 32 + r32) * 136 + ks * 16 + hh * 8), bb = *(const LAS bf16x8*)(VT + (vb * 32 + r32) * 136 + ks * 16 + hh * 8);
                acc = __builtin_amdgcn_mfma_f32_32x32x16_bf16(a, bb, acc, 0, 0, 0); }
#pragma unroll
            for (int ks = 0; ks < 4; ++ks) { const bf16x8 a = *(const LAS bf16x8*)(Qs + (tb * 32 + r32) * 72 + ks * 16 + hh * 8), bb = *(const LAS bf16x8*)(Cs + (vb * 32 + r32) * 72 + ks * 16 + hh * 8);
                acc2 = __builtin_amdgcn_mfma_f32_32x32x16_bf16(a, bb, acc2, 0, 0, 0); } }
        __syncthreads();
        { const int tb = wave >> 1, vb = wave & 1; const int v = vb * 32 + r32;
#pragma unroll
            for (int r = 0; r < 16; ++r) { const int t = tb * 32 + crow(r, hh); const float hv = (acc[r] + vI[t] * acc2[r]) * vD[t];
                if (dir == 0) Hs[t * 65 + v] = hv; else Hs[t * 65 + v] += hv; } }
        __syncthreads();
    }
    { const float g = A.in[I_MLG][layer * 256 + h * 64 + lane];
#pragma unroll 2
        for (int i = 0; i < 16; ++i) { const int t = wave * 16 + i; const float op = bf2f(P[(size_t)(row0 + t) * NP + C_MO + h * 64 + lane]);
            const float x = Hs[t * 65 + lane] * sigmoidf_(op); const float mean = wave_sum(x) * (1.f / 64.f); const float d = x - mean;
            const float rstd = 1.f / sqrtf(wave_sum(d * d) * (1.f / 64.f) + LN_EPS);
            mix[(size_t)(row0 + t) * DM + 768 + h * 64 + lane] = (bf16_t)f2bf(d * rstd * g); } }
    __syncthreads();
}
namespace att {
constexpr int NW = 8, QBLK = 32, KVBLK = 64;
constexpr int SHM_V = KVBLK * 64 * 2, SHM_K = KVBLK * 256;
constexpr int OFF_V = 0, OFF_K = 2 * SHM_V, OFF_WS = OFF_K + 2 * SHM_K, OFF_OST = OFF_WS + NW * 64 * 4, LDS_ATT = OFF_OST + NW * 4096;
constexpr float THR = 8.f;
#define KSWZ(row, colB) ((row) * 256 + ((colB) ^ (((row) & 7) << 4)))
#define SBAR() __builtin_amdgcn_sched_barrier(0)
__device__ __forceinline__ unsigned cvtpk(float lo, float hi) { unsigned r; asm volatile("v_cvt_pk_bf16_f32 %0, %1, %2" : "=v"(r) : "v"(lo), "v"(hi)); return r; }
__device__ __forceinline__ void partialSM(f32x16& p0, f32x16& p1, float& m_reg, float& mn, float& alpha) {
    float pmax = p0[0];
#pragma unroll
    for (int r = 1; r < 16; ++r) pmax = fmaxf(pmax, p0[r]);
#pragma unroll
    for (int r = 0; r < 16; ++r) pmax = fmaxf(pmax, p1[r]);
    { auto rr = __builtin_amdgcn_permlane32_swap(__float_as_uint(pmax), __float_as_uint(pmax), false, false); pmax = fmaxf(__uint_as_float(rr[0]), __uint_as_float(rr[1])); }
    if (__builtin_expect(__all(pmax - m_reg <= THR), 1)) { mn = m_reg; alpha = 1.f; }
    else { mn = fmaxf(m_reg, pmax); alpha = __builtin_amdgcn_exp2f(m_reg - mn); m_reg = mn; }
#pragma unroll
    for (int r = 0; r < 16; ++r) { p0[r] -= mn; p1[r] -= mn; }
#pragma unroll
    for (int r = 0; r < 16; ++r) p0[r] = __builtin_amdgcn_exp2f(p0[r]);
}
__device__ __forceinline__ void finishSM(f32x16& p0, f32x16& p1, float alpha, float& l_reg, bf16x8& pa0, bf16x8& pa1, bf16x8& pa2, bf16x8& pa3) {
#pragma unroll
    for (int r = 0; r < 16; ++r) p1[r] = __builtin_amdgcn_exp2f(p1[r]);
    float ps = 0;
#pragma unroll
    for (int r = 0; r < 16; ++r) ps += p0[r];
#pragma unroll
    for (int r = 0; r < 16; ++r) ps += p1[r];
    { auto rr = __builtin_amdgcn_permlane32_swap(__float_as_uint(ps), __float_as_uint(ps), false, false); ps = __uint_as_float(rr[0]) + __uint_as_float(rr[1]); }
    l_reg = l_reg * alpha + ps;
#define PK4(P, BASE, OUT) do { unsigned a0 = cvtpk(P[BASE + 0], P[BASE + 1]), a1 = cvtpk(P[BASE + 2], P[BASE + 3]);   \
    unsigned b0 = cvtpk(P[BASE + 4], P[BASE + 5]), b1 = cvtpk(P[BASE + 6], P[BASE + 7]);                              \
    auto r0 = __builtin_amdgcn_permlane32_swap(a0, b0, false, false); auto r1 = __builtin_amdgcn_permlane32_swap(a1, b1, false, false); \
    u32x4 w = {r0[0], r1[0], r0[1], r1[1]}; OUT = *reinterpret_cast<bf16x8*>(&w); } while (0)
    PK4(p0, 0, pa0); PK4(p0, 8, pa1); PK4(p1, 0, pa2); PK4(p1, 8, pa3);
#undef PK4
}
__device__ __forceinline__ void qkt(f32x16& p0, f32x16& p1, const char* Ks, const bf16x8* qr, int r32, int hi) {
    p0 = f32x16{}; p1 = f32x16{};
#pragma unroll
    for (int d0 = 0; d0 < 6; ++d0) { const int cb = (d0 * 16 + hi * 8) * 2;
        const bf16x8 b0 = *reinterpret_cast<const bf16x8*>(Ks + KSWZ(r32, cb));
        const bf16x8 b1 = *reinterpret_cast<const bf16x8*>(Ks + KSWZ(32 + r32, cb));
        p0 = __builtin_amdgcn_mfma_f32_32x32x16_bf16(b0, qr[d0], p0, 0, 0, 0);
        p1 = __builtin_amdgcn_mfma_f32_32x32x16_bf16(b1, qr[d0], p1, 0, 0, 0); }
}
__device__ __forceinline__ int v_st(int k, int c) { const int kk = (k & ~0xC) | ((k & 4) << 1) | ((k & 8) >> 1); return ((kk >> 3) * 2 + (c >> 5)) * 512 + ((kk & 7) * 32 + (c & 31)) * 2; }
__device__ __forceinline__ int v_rd_base(int lane) { return ((lane & 3) << 3) | (((lane >> 2) & 3) << 6) | (((lane >> 4) & 1) << 5) | (((lane >> 5) & 1) << 8); }
constexpr int v_rd_off(int d0, int ks, int half) { return d0 * 512 + ks * 2048 + half * 1024; }
template <int OFF> __device__ __forceinline__ s16x4 tr_read(int vb) { s16x4 r; asm volatile("ds_read_b64_tr_b16 %0, %1 offset:%2" : "=&v"(r) : "v"(vb), "i"(OFF) : "memory"); return r; }
template <int D0> __device__ __forceinline__ void pv_one(f32x16& od, int vb, bf16x8 pa0, bf16x8 pa1, bf16x8 pa2, bf16x8 pa3) {
    const s16x4 l0 = tr_read<v_rd_off(D0, 0, 0)>(vb), h0 = tr_read<v_rd_off(D0, 0, 1)>(vb), l1 = tr_read<v_rd_off(D0, 1, 0)>(vb), h1 = tr_read<v_rd_off(D0, 1, 1)>(vb);
    const s16x4 l2 = tr_read<v_rd_off(D0, 2, 0)>(vb), h2 = tr_read<v_rd_off(D0, 2, 1)>(vb), l3 = tr_read<v_rd_off(D0, 3, 0)>(vb), h3 = tr_read<v_rd_off(D0, 3, 1)>(vb);
    asm volatile("s_waitcnt lgkmcnt(0)" ::: "memory"); SBAR();
#define PK(L, H) (bf16x8){L[0], L[1], L[2], L[3], H[0], H[1], H[2], H[3]}
    od = __builtin_amdgcn_mfma_f32_32x32x16_bf16(pa0, PK(l0, h0), od, 0, 0, 0);
    od = __builtin_amdgcn_mfma_f32_32x32x16_bf16(pa1, PK(l1, h1), od, 0, 0, 0);
    od = __builtin_amdgcn_mfma_f32_32x32x16_bf16(pa2, PK(l2, h2), od, 0, 0, 0);
    od = __builtin_amdgcn_mfma_f32_32x32x16_bf16(pa3, PK(l3, h3), od, 0, 0, 0);
#undef PK
}
__device__ __forceinline__ void pv_d0(f32x16* o, int vb, bf16x8 pa0, bf16x8 pa1, bf16x8 pa2, bf16x8 pa3) { pv_one<0>(o[0], vb, pa0, pa1, pa2, pa3); pv_one<1>(o[1], vb, pa0, pa1, pa2, pa3); }

__device__ __forceinline__ void attn_unit(const bf16_t* __restrict__ Qb, const bf16_t* __restrict__ Kh, const bf16_t* __restrict__ Vh, bf16_t* __restrict__ Ob, int seq, char* lds) {
    const int tid = otid(), wid = __builtin_amdgcn_readfirstlane(tid >> 6), lane = tid & 63, r32 = lane & 31, hi = lane >> 5;
    char* V_lds = lds + OFF_V; char* K_lds = lds + OFF_K;
    float* ws = (float*)(lds + OFF_WS) + wid * 64; float* li_l = ws; float* al_l = ws + 32;
    float m_reg = -1e30f, l_reg = 0; f32x16 o[2] = {}; bf16x8 qr[6];
    const bf16_t* Qw = Qb + (long)(wid * QBLK + r32) * 96 + hi * 8;
#pragma unroll
    for (int d0 = 0; d0 < 6; ++d0) qr[d0] = *reinterpret_cast<const bf16x8*>(Qw + d0 * 16);
    const int c1 = tid < 256 ? 512 + tid : tid;
    const int kw0 = KSWZ(tid / 12, (tid % 12) * 16), kw1 = KSWZ(c1 / 12, (c1 % 12) * 16), vst0 = v_st(tid >> 3, (tid & 7) * 8);
    const int vb0 = (int)(uintptr_t)V_lds + v_rd_base(lane);
    struct { bf16x8 ks0, ks1, vs0; } sr_[2];
#define SLOAD(i, k0) do { sr_[i].ks0 = *reinterpret_cast<const bf16x8*>(Kh + (long)(k0) * 96 + tid * 8); sr_[i].ks1 = *reinterpret_cast<const bf16x8*>(Kh + (long)(k0) * 96 + c1 * 8); \
    sr_[i].vs0 = *reinterpret_cast<const bf16x8*>(Vh + (long)(k0) * 64 + tid * 8); } while (0)
#define SWRITE(b, i) do { *(bf16x8*)(K_lds + (b) * SHM_K + kw0) = sr_[i].ks0; if (tid < 256) *(bf16x8*)(K_lds + (b) * SHM_K + kw1) = sr_[i].ks1; *(bf16x8*)(V_lds + (b) * SHM_V + vst0) = sr_[i].vs0; } while (0)
#define SWAIT() asm volatile("s_waitcnt vmcnt(3)" ::: "memory")
#define RESC(a) do { if (__any((a) < 1.f)) { if (hi == 0) al_l[r32] = (a); asm volatile("s_waitcnt lgkmcnt(0)" ::: "memory"); \
    _Pragma("unroll") for (int d = 0; d < 2; ++d) _Pragma("unroll") for (int r = 0; r < 16; ++r) o[d][r] *= al_l[crow(r, hi)]; } } while (0)
    f32x16 pA0, pA1, pB0, pB1; float mnA, mnB, alA, alB; bf16x8 pa0, pa1, pa2, pa3; const int NT = seq / KVBLK;
    constexpr int SE = 0, SO = 1;
    SLOAD(SE, 0); asm volatile("s_waitcnt vmcnt(0)" ::: "memory"); SWRITE(0, SE); __syncthreads();
    qkt(pA0, pA1, K_lds, qr, r32, hi); partialSM(pA0, pA1, m_reg, mnA, alA);
    SLOAD(SO, KVBLK); if (2 < NT) SLOAD(SE, 2 * KVBLK);
    SWAIT(); SWRITE(1, SO); __syncthreads();
    for (int j = 1; j + 1 < NT; j += 2) {
        SBAR(); qkt(pB0, pB1, K_lds + SHM_K, qr, r32, hi);
        finishSM(pA0, pA1, alA, l_reg, pa0, pa1, pa2, pa3); SBAR();
        SLOAD(SO, (j + 2) * KVBLK); SBAR();
        pv_d0(o, vb0, pa0, pa1, pa2, pa3); partialSM(pB0, pB1, m_reg, mnB, alB);
        __syncthreads(); SWAIT(); SWRITE(0, SE);
        RESC(alB); __syncthreads();
        SBAR(); qkt(pA0, pA1, K_lds, qr, r32, hi);
        finishSM(pB0, pB1, alB, l_reg, pa0, pa1, pa2, pa3); SBAR();
        if (j + 3 < NT) SLOAD(SE, (j + 3) * KVBLK); SBAR();
        pv_d0(o, vb0 + SHM_V, pa0, pa1, pa2, pa3); partialSM(pA0, pA1, m_reg, mnA, alA);
        __syncthreads(); SWAIT(); SWRITE(1, SO);
        RESC(alA); __syncthreads();
    }
    SBAR(); qkt(pB0, pB1, K_lds + SHM_K, qr, r32, hi);
    finishSM(pA0, pA1, alA, l_reg, pa0, pa1, pa2, pa3); SBAR();
    pv_d0(o, vb0, pa0, pa1, pa2, pa3); partialSM(pB0, pB1, m_reg, mnB, alB);
    __syncthreads(); RESC(alB);
    finishSM(pB0, pB1, alB, l_reg, pa0, pa1, pa2, pa3); SBAR();
    pv_d0(o, vb0 + SHM_V, pa0, pa1, pa2, pa3);
    if (hi == 0) li_l[r32] = l_reg; asm volatile("s_waitcnt lgkmcnt(0)" ::: "memory");
    float rli[16];
#pragma unroll
    for (int r = 0; r < 16; ++r) rli[r] = __builtin_amdgcn_rcpf(li_l[crow(r, hi)]);
    bf16_t* stg = (bf16_t*)(lds + OFF_OST) + wid * 2048;
#pragma unroll
    for (int r = 0; r < 16; ++r) { const int orow = crow(r, hi);
#pragma unroll
        for (int d0 = 0; d0 < 2; ++d0) stg[orow * 64 + d0 * 32 + r32] = (bf16_t)f2bf(o[d0][r] * rli[r]); }
    asm volatile("s_waitcnt lgkmcnt(0)" ::: "memory");
    bf16_t* Ow = Ob + (long)(wid * QBLK) * DM;
#pragma unroll
    for (int i = 0; i < 4; ++i) { const int row = i * 8 + (lane >> 3), ch = lane & 7; const u32x4 v = *(const u32x4*)(stg + row * 64 + ch * 8); *(u32x4*)(Ow + (long)row * DM + ch * 8) = v; }
    __syncthreads();
#undef SLOAD
#undef SWRITE
#undef SWAIT
#undef RESC
}
#undef KSWZ
#undef SBAR
}

constexpr int NPHASE = 2 + 9 * DEPTH;
constexpr int N_LAUNCHES = MK_N_LAUNCHES;

__global__ void __launch_bounds__(NWAVES * 64, 2) fwd_kernel(Args args) {
    extern __shared__ __attribute__((aligned(16))) unsigned char lds_raw[];
    Frame F;
    F.lds = (LAS unsigned char*)lds_raw;
    F.tid = threadIdx.x; F.lane = F.tid & 63; F.wave = __builtin_amdgcn_readfirstlane(F.tid >> 6);
    F.G = gridDim.x; { const int bx = blockIdx.x; F.vcu = (F.G % 8 == 0) ? (bx % 8) * (F.G / 8) + bx / 8 : bx; }
    F.out = args.out; F.ws = args.ws;
    volatile LAS unsigned* MISC = (volatile LAS unsigned*)(F.lds + LDSCTL_OFF);
    for (int u = F.tid; u < (LDS_BYTES - LDSCTL_OFF) / 4; u += NWAVES * 64) MISC[u] = 0u;
    __syncthreads();
    XcdBarrier bar; bar.bar = (unsigned*)(F.ws + WS_CTL) + CW_BAR; bar.x = 0; bar.st = nullptr;
    if (N_LAUNCHES == 1) bar = xcd_barrier_post((unsigned*)(F.ws + WS_CTL) + CW_BAR, MISC + 8);
    const int lo = args.ph_lo, hi = args.ph_hi;
#ifndef PHM
#define PHM 0xFFFFFFF
#endif
#define IN(k) (lo <= (k) && (k) < hi)
#define EN(j) ((PHM >> (j)) & 1)
#define SEAM(k) do { if (IN(k) && IN((k) + 1)) xcd_barrier(bar); } while (0)

    if (EN(0) && IN(0)) { p0_prologue(F, args); } SEAM(0);
    if (EN(1) && IN(1)) { p1_xm(F, args); } SEAM(1);
#pragma unroll 1
    for (int layer = 0; layer < DEPTH; ++layer) {
        const int pb = 2 + 9 * layer; const bool last = (layer == DEPTH - 1);
        const int Mtok = last ? ML : MT;
        if (EN(2) && IN(pb + 0)) {
            pg8::Gemm g{(const bf16_t*)(F.ws + WS_XM), wptr(F, layer, W_IN), MT, NP, DM, DM}; pg8::StaticOrder S; S.init(MT, NP, F.G, (int)blockIdx.x);
            pg8::Epi8<FInProj> E{FInProj{(bf16_t*)(F.ws + WS_P), (float*)(F.ws + WS_GATE)}};
            pg8::gemm_phase<pg8::Epi8<FInProj>, pg8::StaticOrder, true>(F.lds, g, S, E);
        }
        SEAM(pb + 0);
        if (EN(3) && IN(pb + 1)) {
            if (EN(20)) pb_rows(F, args);
            const int nconv = NB * 32 + (last ? 0 : NB * 4);
            if (EN(21)) for (int t = F.vcu; t < nconv; t += F.G) { if (t < NB * 32) conv_task(F, args, layer, t >> 5, t & 31, false); else { const int u = t - NB * 32; conv_task(F, args, layer, u >> 2, u & 3, true); } }
            if (EN(22)) for (int t = F.vcu; t < NB * MLH * NCHUNK; t += F.G) { const int ci = t % NCHUNK, bh = t / NCHUNK; mlstm_local_task(F, args, layer, bh >> 2, bh & 3, ci); }
        }
        SEAM(pb + 1);
        if (EN(4) && IN(pb + 2)) {
            pg8::Gemm g{(const bf16_t*)(F.ws + WS_P), wptr(F, layer, W_UP), MT, NUP, KUP, NP}; pg8::StaticOrder S; S.init(MT, NUP, F.G, (int)blockIdx.x);
            EpiUp E{F.ws};
            if (EN(23)) pg8::gemm_phase<EpiUp, pg8::StaticOrder, true>(F.lds, g, S, E);
            if (EN(24)) for (int t = F.vcu; t < 128 * 8; t += F.G) mlstm_scan_task(F, t);
        }
        SEAM(pb + 2);
        if (EN(5) && IN(pb + 3)) {
            const bf16_t* Q = (const bf16_t*)(F.ws + WS_Q); const bf16_t* QC = (const bf16_t*)(F.ws + WS_QC); const bf16_t* Kb = (const bf16_t*)(F.ws + WS_K); const bf16_t* Vb = (const bf16_t*)(F.ws + WS_V);
            bf16_t* mix = (bf16_t*)(F.ws + WS_MIX);
            if (EN(25)) for (int u = F.vcu; u < NB * NHEAD * 8; u += F.G) { const int bh = u >> 3, qb = u & 7, b = bh >> 3, h = bh & 7;
                att::attn_unit(Q + ((size_t)bh * SEQ + qb * 256) * 96, Kb + (size_t)bh * LKV * 96, Vb + (size_t)bh * LKV * 64, mix + ((size_t)(b * SEQ + qb * 256)) * DM + h * 64, LKV, (char*)lds_raw); }
            if (EN(26) && !last) for (int u = F.vcu; u < NB * NHEAD; u += F.G) { const int bh = u, b = bh >> 3, h = bh & 7;
                att::attn_unit(QC + (size_t)bh * CTXL * 96, Kb + ((size_t)bh * LKV + SEQ) * 96, Vb + ((size_t)bh * LKV + SEQ) * 64, mix + ((size_t)(ML + b * CTXL)) * DM + h * 64, CTXL, (char*)lds_raw); }
            const int nml = NB * MLH * (last ? 16 : 18);
            if (EN(27)) for (int t = F.vcu; t < nml; t += F.G) { int ci, bh; if (last) { ci = 2 + (t & 15); bh = t >> 4; } else { ci = t % NCHUNK; bh = t / NCHUNK; } mlstm_out_task(F, args, layer, bh >> 2, bh & 3, ci); }
        }
        SEAM(pb + 3);
        if (EN(6) && IN(pb + 4)) {
            pg8::Gemm g{(const bf16_t*)(F.ws + WS_MIX), wptr(F, layer, W_OUT), Mtok, DM, DM, DM}; pg8::StaticOrder S; S.init(Mtok, DM, F.G, (int)blockIdx.x);
            pg8::Epi4<FRes> E{FRes{layer == 0 ? args.in[I_X] : F.out, args.in[I_CTX], F.out, (float*)(F.ws + WS_CTXF), modp(F, layer, 0, 2), nullptr}};
            pg8::gemm_phase<pg8::Epi4<FRes>, pg8::StaticOrder, true>(F.lds, g, S, E);
        }
        SEAM(pb + 4);
        if (EN(7) && IN(pb + 5)) ln_pass(F, args, Mtok, args.in[I_LN1G] + layer * DM, args.in[I_LN1B] + layer * DM, true, layer, 3, 4);
        SEAM(pb + 5);
        if (EN(8) && IN(pb + 6)) {
            pg8::Gemm g{(const bf16_t*)(F.ws + WS_XM), wptr(F, layer, W_1), Mtok, DFF, DM, DM}; pg8::StaticOrder S; S.init(Mtok, DFF, F.G, (int)blockIdx.x);
            pg8::Epi8<FMlp1> E{FMlp1{(bf16_t*)(F.ws + WS_H), args.in[I_B1] + layer * DFF}};
            pg8::gemm_phase<pg8::Epi8<FMlp1>, pg8::StaticOrder, true>(F.lds, g, S, E);
        }
        SEAM(pb + 6);
        if (EN(9) && IN(pb + 7)) {
            pg8::Gemm g{(const bf16_t*)(F.ws + WS_H), wptr(F, layer, W_2), Mtok, DM, DFF, DFF}; pg8::StaticOrder S; S.init(Mtok, DM, F.G, (int)blockIdx.x);
            pg8::Epi4<FRes> E{FRes{F.out, (const float*)(F.ws + WS_CTXF), F.out, (float*)(F.ws + WS_CTXF), modp(F, layer, 0, 5), args.in[I_B2] + layer * DM}};
            pg8::gemm_phase<pg8::Epi4<FRes>, pg8::StaticOrder, true>(F.lds, g, S, E);
        }
        SEAM(pb + 7);
        if (EN(10) && IN(pb + 8)) ln_pass(F, args, Mtok, args.in[I_LN2G] + layer * DM, args.in[I_LN2B] + layer * DM, !last, layer + 1, 0, 1);
        if (!last) SEAM(pb + 8);
    }
#undef IN
#undef SEAM
}

extern "C" void kernel_launch(void* const* d_in, const int* in_sizes, int n_in, void* d_out, int out_size, void* d_ws, size_t ws_size, hipStream_t stream) {
    static int grid = 0;
    if (grid == 0) {
        if (n_in != 26 || in_sizes[0] != ML * DM || out_size != ML * DM || ws_size < WS_END) {
            fprintf(stderr, "kernel_launch: shape/workspace mismatch: n_in %d in0 %d out %d ws %zu (need %zu); nothing launched\n", n_in, n_in > 0 ? in_sizes[0] : -1, out_size, ws_size, (size_t)WS_END); grid = -1; return; }
        int dev = 0, cus = 0;
        if (hipGetDevice(&dev) != hipSuccess || hipDeviceGetAttribute(&cus, hipDeviceAttributeMultiprocessorCount, dev) != hipSuccess) { grid = -1; return; }
        if (hipFuncSetAttribute((const void*)fwd_kernel, hipFuncAttributeMaxDynamicSharedMemorySize, LDS_BYTES) != hipSuccess) { fprintf(stderr, "kernel_launch: hipFuncSetAttribute failed\n"); grid = -1; return; }
        int per_cu = 0;
        if (hipOccupancyMaxActiveBlocksPerMultiprocessor(&per_cu, (const void*)fwd_kernel, NWAVES * 64, LDS_BYTES) != hipSuccess || per_cu < 1) fprintf(stderr, "kernel_launch: note: occupancy query reports %d\n", per_cu);
        (void)hipGetLastError();
        grid = cus;
    }
    if (grid < 0) return;
    if (hipMemsetAsync((char*)d_ws + WS_CTL, 0, CTL_ZERO_BYTES, stream) != hipSuccess) return;
    Args a{};
    for (int i = 0; i < 26; ++i) a.in[i] = (const float*)d_in[i];
    a.out = (float*)d_out; a.ws = (unsigned char*)d_ws;
    if (N_LAUNCHES == 1) { a.ph_lo = 0; a.ph_hi = NPHASE; hipLaunchKernelGGL(fwd_kernel, dim3(grid), dim3(NWAVES * 64), LDS_BYTES, stream, a); }
    else for (int p = 0; p < NPHASE; ++p) { a.ph_lo = p; a.ph_hi = p + 1; hipLaunchKernelGGL(fwd_kernel, dim3(grid), dim3(NWAVES * 64), LDS_BYTES, stream, a); }
    const hipError_t le = hipPeekAtLastError();
    if (le != hipSuccess) fprintf(stderr, "kernel_launch: launch failed: %s\n", hipGetErrorName(le));
}
```
